# Optimizing an MI355X kernel written in HIP

```python
import math
import jax, jax.numpy as jnp
from jax import lax
import numpy as np

D_MODEL = 1024
BATCH = 8
SEQ = 8192
DEPTH = 1

HEAD_DIM = 64
DIL_PATTERNS = ((128, 1), (512, 4), (2048, 16))
N_DIL_GROUPS = len(DIL_PATTERNS)
HEADS_PER_GROUP = 4
N_ATTN_HEADS = N_DIL_GROUPS * HEADS_PER_GROUP
ATTN_WIDTH = N_ATTN_HEADS * HEAD_DIM
ATTN_OUT_WIDTH = HEADS_PER_GROUP * HEAD_DIM
QBLK = 128
ROPE_THETA = 10000.0

CHUNK = 128
GMLP_GROUPS = 4
GMLP_GROUP_CH = 128
GMLP_WIDTH = GMLP_GROUPS * GMLP_GROUP_CH

D_FF = 4 * D_MODEL
EPS = 1e-6

Q0 = 0
K0 = Q0 + ATTN_WIDTH
V0 = K0 + ATTN_WIDTH
U0 = V0 + ATTN_WIDTH
Z0 = U0 + GMLP_WIDTH
GA0 = Z0 + GMLP_WIDTH
GB0 = GA0 + D_MODEL
IN_WIDTH = GB0 + D_MODEL

kernel_name = "hybrid_dilated_attn_gmlp_block"


def _rmsnorm(x, gain):
    xf = x.astype(jnp.float32)
    y = xf * lax.rsqrt(jnp.mean(xf * xf, axis=-1, keepdims=True) + EPS)
    return (y * gain.astype(jnp.float32)).astype(x.dtype)


def _layernorm(x, gain, bias):
    xf = x.astype(jnp.float32)
    mu = jnp.mean(xf, axis=-1, keepdims=True)
    var = jnp.mean(jnp.square(xf - mu), axis=-1, keepdims=True)
    y = (xf - mu) * lax.rsqrt(var + EPS)
    return (y * gain.astype(jnp.float32) + bias.astype(jnp.float32)).astype(x.dtype)


def _rope(x):
    S, Dh = x.shape[1], x.shape[-1]
    half = Dh // 2
    inv_freq = ROPE_THETA ** (-jnp.arange(half, dtype=jnp.float32) / half)
    ang = jnp.arange(S, dtype=jnp.float32)[:, None] * inv_freq[None, :]
    cos = jnp.cos(ang)[None, :, None, :]
    sin = jnp.sin(ang)[None, :, None, :]
    xf = x.astype(jnp.float32)
    x1, x2 = xf[..., :half], xf[..., half:]
    return jnp.concatenate([x1 * cos - x2 * sin, x2 * cos + x1 * sin], axis=-1).astype(x.dtype)


def _dilated_window_attention(q, k, v, dilation, n_back):
    B, S, H, Dh = q.shape
    L = S // dilation
    nb = -(-L // QBLK)
    Lp = nb * QBLK

    def to_sub(t):
        t = t.reshape(B, L, dilation, H, Dh).transpose(0, 2, 3, 1, 4)
        t = jnp.pad(t, ((0, 0), (0, 0), (0, 0), (0, Lp - L), (0, 0)))
        return t.reshape(B, dilation, H, nb, QBLK, Dh)

    def with_prev(t):
        prev = jnp.pad(t[:, :, :, :-1], ((0, 0), (0, 0), (0, 0), (1, 0), (0, 0), (0, 0)))
        return jnp.concatenate([prev, t], axis=4)

    qb, kb, vb = to_sub(q), to_sub(k), to_sub(v)
    kc, vc = with_prev(kb), with_prev(vb)
    s = jnp.einsum('brhnqe,brhnke->brhnqk', qb.astype(jnp.float32),
                   kc.astype(jnp.float32)) * (Dh ** -0.5)
    qi = jnp.arange(QBLK)[:, None]
    kj = jnp.arange(2 * QBLK)[None, :]
    dist = qi + QBLK - kj
    band = (dist >= 0) & (dist <= n_back)
    key_sub = jnp.arange(nb)[:, None, None] * QBLK + kj[None] - QBLK
    mask = band[None] & (key_sub >= 0)
    s = jnp.where(mask, s, jnp.float32(-1e30))
    m = jnp.max(s, axis=-1, keepdims=True)
    p = jnp.exp(s - m)
    den = jnp.sum(p, axis=-1, keepdims=True)
    o = jnp.einsum('brhnqk,brhnke->brhnqe', p, vc.astype(jnp.float32)) / den
    lse = (m + jnp.log(den))[..., 0]
    o = o.reshape(B, dilation, H, Lp, Dh)[:, :, :, :L].transpose(0, 3, 1, 2, 4).reshape(B, S, H, Dh)
    lse = lse.reshape(B, dilation, H, Lp)[:, :, :, :L].transpose(0, 3, 1, 2).reshape(B, S, H)
    return o, lse


def _mixer_dilated_attention(q, k, v):
    B, S = q.shape[0], q.shape[1]
    outs, lses = [], []
    for g, (window, dilation) in enumerate(DIL_PATTERNS):
        sl = slice(g * HEADS_PER_GROUP, (g + 1) * HEADS_PER_GROUP)
        o, lse = _dilated_window_attention(q[:, :, sl], k[:, :, sl], v[:, :, sl],
                                           dilation, window // dilation)
        outs.append(o)
        lses.append(lse)
    alpha = jax.nn.softmax(jnp.stack(lses, axis=0), axis=0)
    o = jnp.sum(alpha[..., None] * jnp.stack(outs, axis=0), axis=0)
    return o.reshape(B, S, ATTN_OUT_WIDTH).astype(q.dtype)


def _mixer_chunked_gmlp(u, z, ln_gain, ln_bias, w_spatial, b_spatial):
    B, S, _ = u.shape
    nc = S // CHUNK
    z = _layernorm(z, ln_gain, ln_bias)
    zc = z.reshape(B, nc, CHUNK, GMLP_GROUPS, GMLP_GROUP_CH)
    tril = jnp.tril(jnp.ones((CHUNK, CHUNK), dtype=bool))
    w = jnp.where(tril[None], w_spatial, jnp.zeros_like(w_spatial))
    sz = jnp.einsum('gij,bcjgd->bcigd', w.astype(jnp.float32), zc.astype(jnp.float32))
    sz = sz + b_spatial.T.astype(jnp.float32)[None, None, :, :, None]
    out = u.reshape(B, nc, CHUNK, GMLP_GROUPS, GMLP_GROUP_CH).astype(jnp.float32) * sz
    return out.reshape(B, S, GMLP_WIDTH).astype(u.dtype)


def setup_inputs(seed: int = 0) -> dict:
    key = jax.random.key(seed)
    ks = jax.random.split(key, 16)
    f32 = jnp.float32

    def dense(k, fan_in, fan_out):
        return jax.random.normal(k, (DEPTH, fan_in, fan_out), f32) * (fan_in ** -0.5)

    def gain(k, n):
        return 1.0 + 0.02 * jax.random.normal(k, (DEPTH, n), f32)

    return {
        "x": jax.random.normal(ks[0], (BATCH, SEQ, D_MODEL), f32),
        "norm_pre_mix": gain(ks[1], D_MODEL),
        "w_in": dense(ks[2], D_MODEL, IN_WIDTH),
        "w_spatial": jax.random.normal(ks[3], (DEPTH, GMLP_GROUPS, CHUNK, CHUNK), f32) * (CHUNK ** -0.5),
        "b_spatial": 1.0 + 0.1 * jax.random.normal(ks[4], (DEPTH, GMLP_GROUPS, CHUNK), f32),
        "ln_v_gain": gain(ks[5], GMLP_WIDTH),
        "ln_v_bias": 0.02 * jax.random.normal(ks[6], (DEPTH, GMLP_WIDTH), f32),
        "w_branch_attn": dense(ks[7], ATTN_OUT_WIDTH, D_MODEL),
        "w_branch_gmlp": dense(ks[8], GMLP_WIDTH, D_MODEL),
        "w_out": dense(ks[9], D_MODEL, D_MODEL),
        "norm_post_mix": gain(ks[10], D_MODEL),
        "norm_pre_mlp": gain(ks[11], D_MODEL),
        "w_mlp_in": dense(ks[12], D_MODEL, D_FF),
        "w_mlp_out": dense(ks[13], D_FF, D_MODEL),
        "norm_post_mlp": gain(ks[14], D_MODEL),
    }


def reference(x, norm_pre_mix, w_in, w_spatial, b_spatial, ln_v_gain, ln_v_bias,
              w_branch_attn, w_branch_gmlp, w_out, norm_post_mix, norm_pre_mlp,
              w_mlp_in, w_mlp_out, norm_post_mlp):
    B, S, D = x.shape
    for layer in range(DEPTH):
        h = _rmsnorm(x, norm_pre_mix[layer])
        proj = jnp.einsum('bsd,de->bse', h, w_in[layer])
        q = _rope(proj[..., Q0:K0].reshape(B, S, N_ATTN_HEADS, HEAD_DIM))
        k = _rope(proj[..., K0:V0].reshape(B, S, N_ATTN_HEADS, HEAD_DIM))
        v = proj[..., V0:U0].reshape(B, S, N_ATTN_HEADS, HEAD_DIM)
        u = jax.nn.gelu(proj[..., U0:Z0])
        z = jax.nn.gelu(proj[..., Z0:GA0])
        gate_a = jax.nn.sigmoid(proj[..., GA0:GB0])
        gate_b = jax.nn.sigmoid(proj[..., GB0:IN_WIDTH])

        y_attn = _mixer_dilated_attention(q, k, v)
        y_gmlp = _mixer_chunked_gmlp(u, z, ln_v_gain[layer], ln_v_bias[layer],
                                     w_spatial[layer], b_spatial[layer])
        merged = (gate_a * jnp.einsum('bse,ed->bsd', y_attn, w_branch_attn[layer])
                  + gate_b * jnp.einsum('bse,ed->bsd', y_gmlp, w_branch_gmlp[layer]))
        y = jnp.einsum('bsd,de->bse', merged, w_out[layer])
        x = x + _rmsnorm(y, norm_post_mix[layer])

        h = _rmsnorm(x, norm_pre_mlp[layer])
        a = jax.nn.relu(jnp.einsum('bsd,df->bsf', h, w_mlp_in[layer]))
        y = jnp.einsum('bsf,fd->bsd', a * a, w_mlp_out[layer])
        x = x + _rmsnorm(y, norm_post_mlp[layer])
    return x
```

```cpp
#include <hip/hip_runtime.h>
#include <cstdio>
#include <cstdint>

#define LAS __attribute__((address_space(3)))
typedef unsigned short bf16_t;
typedef short bf16x8 __attribute__((ext_vector_type(8)));
typedef short s16x4 __attribute__((ext_vector_type(4)));
typedef float f32x4 __attribute__((ext_vector_type(4)));
typedef float f32x2 __attribute__((ext_vector_type(2)));
typedef unsigned u32x4 __attribute__((ext_vector_type(4)));
typedef unsigned u32x2 __attribute__((ext_vector_type(2)));
typedef __bf16 bf16x2_t __attribute__((ext_vector_type(2)));

constexpr int BATCH = 8, SEQ = 8192, DM = 1024, MROWS = BATCH * SEQ;
constexpr int AW = 768, AOW = 256, GW = 512, DFF = 4096, INW = 5376;
constexpr float EPS = 1e-6f;
constexpr float QSCALE = 0.125f * 1.4426950408889634f;

__device__ __forceinline__ unsigned cvtpk(float lo, float hi) { f32x2 v = {lo, hi}; bf16x2_t b = __builtin_convertvector(v, bf16x2_t); return __builtin_bit_cast(unsigned, b); }
__device__ __forceinline__ float bflo(unsigned u) { return __uint_as_float(u << 16); }
__device__ __forceinline__ float bfhi(unsigned u) { return __uint_as_float(u & 0xffff0000u); }
__device__ __forceinline__ float gelu_tanh(float x) {
    const float t = x * (1.5957691216057308f + 0.07135481627159498f * x * x);
    return x * __builtin_amdgcn_rcpf(1.0f + __builtin_amdgcn_exp2f(-1.4426950408889634f * t));
}
__device__ __forceinline__ float sigmoidf_(float x) { return __builtin_amdgcn_rcpf(1.0f + __builtin_amdgcn_exp2f(-1.4426950408889634f * x)); }

namespace pg8 {
constexpr int BM = 256, BK = 64, HALF = 128, HTB = HALF * BK * 2, STAGE_BYTES = 8 * HTB, NXCD = 8, WGM = 8;
__host__ __device__ __forceinline__ int lds_byte(int r, int c) { const int st = (r >> 4) * 2 + (c >> 5), rr = r & 15, cc = c & 31, ob = rr * 64 + cc * 2; return st * 1024 + (ob ^ (((ob >> 9) & 1) << 5)); }
__host__ __device__ __forceinline__ void stage_rc(int b, int& R, int& C) { const int st = b / 1024, sb = b % 1024, swz = sb ^ (((sb >> 9) & 1) << 5); R = (st >> 1) * 16 + swz / 64; C = (st & 1) * 32 + (swz % 64) / 2; }
__host__ __device__ __forceinline__ int perm32(int rho) { const int n = rho >> 4, i = rho & 15; return 8 * (i >> 2) + 4 * n + (i & 3); }

struct Unit { int pm, pn, kind; };
struct Gemm { const bf16_t* A0; const bf16_t* A1; const bf16_t* B0; const bf16_t* B1; int nt0, nt1, lda, ldb; };

struct StaticOrder {
    int nM, nN, nwg, G, c, reps;
    __device__ void init(int M, int N, int G_, int c_, int reps_) { nM = M / BM; nN = N / BM; nwg = nM * nN; G = G_; c = c_; reps = reps_; }
    __device__ bool next(int i, Unit& u) const {
        const int it = (reps == 2) ? (i >> 1) : i; u.kind = (reps == 2) ? (i & 1) : 0;
        const long L = (long)it * G + c; if (L >= nwg) return false;
        int wgid = (int)L; { const int q = nwg / NXCD, r = nwg % NXCD, xcd = wgid % NXCD, off = wgid / NXCD; wgid = (xcd < r ? xcd * (q + 1) : r * (q + 1) + (xcd - r) * q) + off; }
        const int nig = WGM * nN, gid = wgid / nig, fm = gid * WGM, gsz = (nM - fm) < WGM ? (nM - fm) : WGM;
        u.pm = fm + ((wgid % nig) % gsz); u.pn = (wgid % nig) / gsz; return true;
    }
};

template <class Epi, bool ALIGN_EPI>
__device__ __forceinline__ void gemm_phase(LAS unsigned char* lds, const Gemm g, const StaticOrder& S, const Epi& E) {
    const int tid = threadIdx.x, wid = __builtin_amdgcn_readfirstlane(tid >> 6), lane = tid & 63, wr = wid >> 2, wc = wid & 3, fr = lane & 15, fq = lane >> 4;
    unsigned voffA[2], voffB[2];
#pragma unroll
    for (int i = 0; i < 2; ++i) { int R, C; stage_rc(tid * 16 + i * 8192, R, C); const int Rb = (R & ~31) + perm32(R & 31);
        voffA[i] = (unsigned)(R * g.lda + C) * 2u; voffB[i] = (unsigned)(Rb * g.ldb + C) * 2u; }
    const size_t kstep = (size_t)(BK * 2);
    const size_t hstepA = (size_t)HALF * g.lda * 2, hstepB = (size_t)HALF * g.ldb * 2;
    const size_t tstepA = 2 * hstepA, tstepB = 2 * hstepB;
    const unsigned ldsw = (unsigned)wid * 1024u;
    const int aoff = lds_byte(wr * 64 + fr, fq * 8), boff = lds_byte(wc * 32 + fr, fq * 8);
#define PG8_SA(b, h) (((b) * 2 + (h)) * HTB)
#define PG8_SB(b, h) ((4 + (b) * 2 + (h)) * HTB)
#define PG8_STAGE(bufoff, gbase, voff) do { _Pragma("unroll") for (int _i = 0; _i < 2; ++_i) \
        __builtin_amdgcn_global_load_lds((const unsigned*)((const char*)(gbase) + (voff)[_i]), (LAS unsigned*)(lds + (bufoff) + ldsw + _i * 8192), 16, 0, 0); } while (0)
#define PG8_LDA(dst, b, h) do { _Pragma("unroll") for (int m = 0; m < 4; ++m) _Pragma("unroll") for (int k = 0; k < 2; ++k) dst[m][k] = *(const LAS bf16x8*)(lds + PG8_SA(b, h) + aoff + m * 2048 + k * 1024); } while (0)
#define PG8_LDB(dst, b, h) do { _Pragma("unroll") for (int n = 0; n < 2; ++n) _Pragma("unroll") for (int k = 0; k < 2; ++k) dst[n][k] = *(const LAS bf16x8*)(lds + PG8_SB(b, h) + boff + n * 2048 + k * 1024); } while (0)
#define PG8_MMA(ai, bj, At, Bt) do { __builtin_amdgcn_s_setprio(1); _Pragma("unroll") for (int m = 0; m < 4; ++m) _Pragma("unroll") for (int n = 0; n < 2; ++n) _Pragma("unroll") for (int k = 0; k < 2; ++k) \
        acc[ai][bj][m][n] = __builtin_amdgcn_mfma_f32_16x16x32_bf16(Bt[n][k], At[m][k], acc[ai][bj][m][n], 0, 0, 0); __builtin_amdgcn_s_setprio(0); } while (0)
#define PG8_WAIT_V(n) asm volatile("s_waitcnt vmcnt(" #n ")" ::: "memory")
#define PG8_WAIT_L(n) asm volatile("s_waitcnt lgkmcnt(" #n ")" ::: "memory")
#define PG8_BAR __builtin_amdgcn_s_barrier()
#define PG8_SCHED __builtin_amdgcn_sched_barrier(0)
    Unit cur, nxt; int ui = 0;
    if (!S.next(0, cur)) return;
    f32x4 acc[2][2][4][2];
#pragma unroll
    for (int a = 0; a < 2; ++a)
#pragma unroll
        for (int b = 0; b < 2; ++b)
#pragma unroll
            for (int m = 0; m < 4; ++m)
#pragma unroll
                for (int n = 0; n < 2; ++n) acc[a][b][m][n] = (f32x4){0.f, 0.f, 0.f, 0.f};
    bf16x8 At[4][2], B0[2][2], B1[2][2];
    const char* cA = (const char*)(cur.kind ? g.A1 : g.A0) + (size_t)cur.pm * tstepA; const char* cB = (const char*)(cur.kind ? g.B1 : g.B0) + (size_t)cur.pn * tstepB;
    int nt = cur.kind ? g.nt1 : g.nt0;
    PG8_STAGE(PG8_SB(0, 0), cB, voffB); PG8_STAGE(PG8_SB(0, 1), cB + hstepB, voffB); PG8_STAGE(PG8_SA(0, 0), cA, voffA); PG8_STAGE(PG8_SA(0, 1), cA + hstepA, voffA);
    if (wr == 1) PG8_BAR;
    PG8_WAIT_V(2); PG8_BAR;
    PG8_STAGE(PG8_SB(1, 0), cB + kstep, voffB); PG8_STAGE(PG8_SA(1, 0), cA + kstep, voffA); PG8_STAGE(PG8_SB(1, 1), cB + hstepB + kstep, voffB);
    PG8_WAIT_V(6); PG8_BAR;
    for (;;) {
        const bool has_next = S.next(ui + 1, nxt);
        const char* nA = has_next ? (const char*)(nxt.kind ? g.A1 : g.A0) + (size_t)nxt.pm * tstepA : cA; const char* nB = has_next ? (const char*)(nxt.kind ? g.B1 : g.B0) + (size_t)nxt.pn * tstepB : cB;
        for (int t = 0; t < nt; t += 2) {
            const bool last = (t == nt - 2);
            const char* a1 = cA + (size_t)(t + 1) * kstep;
            const char* a2 = last ? nA : cA + (size_t)(t + 2) * kstep; const char* b2 = last ? nB : cB + (size_t)(t + 2) * kstep;
            const char* a3 = a2 + kstep; const char* b3 = b2 + kstep;
            PG8_LDB(B0, 0, 0); PG8_LDB(B1, 0, 1); PG8_SCHED; PG8_LDA(At, 0, 0); PG8_STAGE(PG8_SA(1, 1), a1 + hstepA, voffA);
            PG8_WAIT_V(8); PG8_WAIT_L(0); PG8_BAR; PG8_MMA(0, 0, At, B0); PG8_MMA(0, 1, At, B1); PG8_BAR; PG8_SCHED;
            PG8_LDA(At, 0, 1); PG8_STAGE(PG8_SB(0, 0), b2, voffB); PG8_STAGE(PG8_SB(0, 1), b2 + hstepB, voffB); PG8_STAGE(PG8_SA(0, 0), a2, voffA);
            PG8_WAIT_V(8); PG8_WAIT_L(0); PG8_BAR; PG8_MMA(1, 0, At, B0); PG8_MMA(1, 1, At, B1); PG8_BAR; PG8_SCHED;
            PG8_LDB(B0, 1, 0); PG8_LDB(B1, 1, 1); PG8_SCHED; PG8_LDA(At, 1, 0); PG8_STAGE(PG8_SA(0, 1), a2 + hstepA, voffA);
            PG8_WAIT_V(8); PG8_WAIT_L(0); PG8_BAR; PG8_MMA(0, 0, At, B0); PG8_MMA(0, 1, At, B1); PG8_BAR; PG8_SCHED;
            PG8_LDA(At, 1, 1); PG8_STAGE(PG8_SB(1, 0), b3, voffB); PG8_STAGE(PG8_SB(1, 1), b3 + hstepB, voffB); PG8_STAGE(PG8_SA(1, 0), a3, voffA);
            PG8_WAIT_V(8); PG8_WAIT_L(0); PG8_BAR; PG8_MMA(1, 0, At, B0); PG8_MMA(1, 1, At, B1); PG8_BAR; PG8_SCHED;
        }
        if constexpr (ALIGN_EPI) { if (wr == 0) PG8_BAR; }
        E(acc, cur, wr, wc, fr, fq);
        if (!has_next) break;
#pragma unroll
        for (int a = 0; a < 2; ++a)
#pragma unroll
            for (int b = 0; b < 2; ++b)
#pragma unroll
                for (int m = 0; m < 4; ++m)
#pragma unroll
                    for (int n = 0; n < 2; ++n) acc[a][b][m][n] = (f32x4){0.f, 0.f, 0.f, 0.f};
        cur = nxt; cA = nA; cB = nB; nt = cur.kind ? g.nt1 : g.nt0; ++ui;
        if constexpr (ALIGN_EPI) { if (wr == 1) PG8_BAR; }
    }
    PG8_WAIT_V(0);
    if constexpr (!ALIGN_EPI) { if (wr == 0) PG8_BAR; }
    PG8_BAR;
#undef PG8_SA
#undef PG8_SB
#undef PG8_STAGE
#undef PG8_LDA
#undef PG8_LDB
#undef PG8_MMA
#undef PG8_WAIT_V
#undef PG8_WAIT_L
#undef PG8_BAR
#undef PG8_SCHED
}

#define EPI_ROWS_BEGIN  _Pragma("unroll") for (int ai = 0; ai < 2; ++ai) _Pragma("unroll") for (int m = 0; m < 4; ++m) { const int r = u.pm * BM + ai * HALF + wr * 64 + m * 16 + fr; _Pragma("unroll") for (int bj = 0; bj < 2; ++bj) { \
        const f32x4 v0 = acc[ai][bj][m][0], v1 = acc[ai][bj][m][1]; const int c0 = u.pn * BM + bj * HALF + wc * 32 + fq * 8; (void)r; (void)c0;
#define EPI_ROWS_END } }
__device__ __forceinline__ u32x4 pack8(f32x4 a, f32x4 b) { u32x4 w; w.x = cvtpk(a[0], a[1]); w.y = cvtpk(a[2], a[3]); w.z = cvtpk(b[0], b[1]); w.w = cvtpk(b[2], b[3]); return w; }

struct EpiP1 {
    bf16_t *Q, *K, *V, *U, *Z, *GA, *GB; f32x2* zst; const float* rope;
    __device__ __forceinline__ void operator()(const f32x4 (&acc)[2][2][4][2], const Unit& u, int wr, int wc, int fr, int fq) const {
        const int pn = u.pn;
        if (pn < 6) {
            bf16_t* O = pn < 3 ? Q : K; const int cb = pn < 3 ? 0 : AW; const float sc = pn < 3 ? QSCALE : 1.0f;
            const int i0 = (wc & 1) * 16 + fq * 4;
            EPI_ROWS_BEGIN
                const float* tp = rope + ((size_t)(r & (SEQ - 1)) * 32 + i0) * 2;
                const f32x4 t0 = *(const f32x4*)tp, t1 = *(const f32x4*)(tp + 4);
                f32x4 o0, o1;
                o0[0] = (v0[0] * t0[0] - v0[1] * t0[1]) * sc; o0[1] = (v0[1] * t0[0] + v0[0] * t0[1]) * sc;
                o0[2] = (v0[2] * t0[2] - v0[3] * t0[3]) * sc; o0[3] = (v0[3] * t0[2] + v0[2] * t0[3]) * sc;
                o1[0] = (v1[0] * t1[0] - v1[1] * t1[1]) * sc; o1[1] = (v1[1] * t1[0] + v1[0] * t1[1]) * sc;
                o1[2] = (v1[2] * t1[2] - v1[3] * t1[3]) * sc; o1[3] = (v1[3] * t1[2] + v1[2] * t1[3]) * sc;
                *(u32x4*)(O + (size_t)r * AW + (c0 - cb)) = pack8(o0, o1);
            EPI_ROWS_END
        } else if (pn < 9) {
            EPI_ROWS_BEGIN
                *(u32x4*)(V + (size_t)r * AW + (c0 - 2 * AW)) = pack8(v0, v1);
            EPI_ROWS_END
        } else if (pn < 11) {
            EPI_ROWS_BEGIN
                f32x4 o0, o1;
#pragma unroll
                for (int e = 0; e < 4; ++e) { o0[e] = gelu_tanh(v0[e]); o1[e] = gelu_tanh(v1[e]); }
                *(u32x4*)(U + (size_t)r * GW + (c0 - 3 * AW)) = pack8(o0, o1);
            EPI_ROWS_END
        } else if (pn < 13) {
#pragma unroll
            for (int ai = 0; ai < 2; ++ai)
#pragma unroll
                for (int m = 0; m < 4; ++m) { const int r = u.pm * BM + ai * HALF + wr * 64 + m * 16 + fr; float s = 0.f, q = 0.f;
#pragma unroll
                    for (int bj = 0; bj < 2; ++bj) { const f32x4 v0 = acc[ai][bj][m][0], v1 = acc[ai][bj][m][1]; const int c0 = u.pn * BM + bj * HALF + wc * 32 + fq * 8;
                        f32x4 o0, o1;
#pragma unroll
                        for (int e = 0; e < 4; ++e) { o0[e] = gelu_tanh(v0[e]); o1[e] = gelu_tanh(v1[e]); s += o0[e] + o1[e]; q += o0[e] * o0[e] + o1[e] * o1[e]; }
                        *(u32x4*)(Z + (size_t)r * GW + (c0 - 3 * AW - GW)) = pack8(o0, o1); }
                    s += __shfl_xor(s, 16); s += __shfl_xor(s, 32); q += __shfl_xor(q, 16); q += __shfl_xor(q, 32);
                    if (fq == 0) zst[(size_t)r * 8 + (pn - 11) * 4 + wc] = (f32x2){s, q}; }
        } else {
            bf16_t* O = pn < 17 ? GA : GB; const int cb = pn < 17 ? (3 * AW + 2 * GW) : (3 * AW + 2 * GW + DM);
            EPI_ROWS_BEGIN
                f32x4 o0, o1;
#pragma unroll
                for (int e = 0; e < 4; ++e) { o0[e] = sigmoidf_(v0[e]); o1[e] = sigmoidf_(v1[e]); }
                *(u32x4*)(O + (size_t)r * DM + (c0 - cb)) = pack8(o0, o1);
            EPI_ROWS_END
        }
    }
};
struct EpiMerge {
    const bf16_t *GA, *GB; bf16_t* MG;
    __device__ __forceinline__ void operator()(const f32x4 (&acc)[2][2][4][2], const Unit& u, int wr, int wc, int fr, int fq) const {
        if (u.kind == 0) {
            EPI_ROWS_BEGIN
                const u32x4 gw = *(const u32x4*)(GA + (size_t)r * DM + c0);
                f32x4 o0, o1; o0[0] = v0[0] * bflo(gw.x); o0[1] = v0[1] * bfhi(gw.x); o0[2] = v0[2] * bflo(gw.y); o0[3] = v0[3] * bfhi(gw.y);
                o1[0] = v1[0] * bflo(gw.z); o1[1] = v1[1] * bfhi(gw.z); o1[2] = v1[2] * bflo(gw.w); o1[3] = v1[3] * bfhi(gw.w);
                *(u32x4*)(MG + (size_t)r * DM + c0) = pack8(o0, o1);
            EPI_ROWS_END
        } else {
            EPI_ROWS_BEGIN
                const u32x4 gw = *(const u32x4*)(GB + (size_t)r * DM + c0); const u32x4 pw = *(const u32x4*)(MG + (size_t)r * DM + c0);
                f32x4 o0, o1; o0[0] = bflo(pw.x) + v0[0] * bflo(gw.x); o0[1] = bfhi(pw.x) + v0[1] * bfhi(gw.x); o0[2] = bflo(pw.y) + v0[2] * bflo(gw.y); o0[3] = bfhi(pw.y) + v0[3] * bfhi(gw.y);
                o1[0] = bflo(pw.z) + v1[0] * bflo(gw.z); o1[1] = bfhi(pw.z) + v1[1] * bfhi(gw.z); o1[2] = bflo(pw.w) + v1[2] * bflo(gw.w); o1[3] = bfhi(pw.w) + v1[3] * bfhi(gw.w);
                *(u32x4*)(MG + (size_t)r * DM + c0) = pack8(o0, o1);
            EPI_ROWS_END
        }
    }
};
struct EpiYss {
    bf16_t* Y; float* ss;
    __device__ __forceinline__ void operator()(const f32x4 (&acc)[2][2][4][2], const Unit& u, int wr, int wc, int fr, int fq) const {
#pragma unroll
        for (int ai = 0; ai < 2; ++ai)
#pragma unroll
            for (int m = 0; m < 4; ++m) { const int r = u.pm * BM + ai * HALF + wr * 64 + m * 16 + fr; float q = 0.f;
#pragma unroll
                for (int bj = 0; bj < 2; ++bj) { const f32x4 v0 = acc[ai][bj][m][0], v1 = acc[ai][bj][m][1]; const int c0 = u.pn * BM + bj * HALF + wc * 32 + fq * 8;
#pragma unroll
                    for (int e = 0; e < 4; ++e) q += v0[e] * v0[e] + v1[e] * v1[e];
                    *(u32x4*)(Y + (size_t)r * DM + c0) = pack8(v0, v1); }
                q += __shfl_xor(q, 16); q += __shfl_xor(q, 32);
                if (fq == 0) ss[(size_t)r * 16 + u.pn * 4 + wc] = q; }
    }
};
struct EpiRelu2 {
    bf16_t* H;
    __device__ __forceinline__ void operator()(const f32x4 (&acc)[2][2][4][2], const Unit& u, int wr, int wc, int fr, int fq) const {
        EPI_ROWS_BEGIN
            f32x4 o0, o1;
#pragma unroll
            for (int e = 0; e < 4; ++e) { const float a = fmaxf(v0[e], 0.f), b = fmaxf(v1[e], 0.f); o0[e] = a * a; o1[e] = b * b; }
            *(u32x4*)(H + (size_t)r * DFF + c0) = pack8(o0, o1);
        EPI_ROWS_END
    }
};
}

constexpr size_t MiB = 1u << 20;
constexpr size_t WS_CTL = 0, CTL_ZERO_BYTES = 64 * 1024;
constexpr size_t WS_WIN = 1 * MiB, WS_WCAT = 12 * MiB, WS_WOUT = 14 * MiB, WS_WMI = 16 * MiB, WS_WMO = 24 * MiB, WS_WSP = 32 * MiB, WS_ROPE = 33 * MiB;
constexpr size_t WS_ZST = 36 * MiB, WS_SS1 = 40 * MiB, WS_SS2 = 44 * MiB;
constexpr size_t WS_XN = 48 * MiB;
constexpr size_t WS_Q = 176 * MiB, WS_K = 272 * MiB, WS_V = 368 * MiB, WS_U = 464 * MiB, WS_Z = 528 * MiB, WS_GA = 592 * MiB, WS_GB = 720 * MiB, WS_OG = 848 * MiB, WS_LSE = 944 * MiB;
constexpr size_t WS_MG = 176 * MiB;
constexpr size_t WS_Y = 464 * MiB;
constexpr size_t WS_H = 176 * MiB;
constexpr size_t WS_END = 948 * MiB;
constexpr int CW_BAR = 1024;

constexpr int RING_BYTES = 131072, LDSCTL_OFF = RING_BYTES, MISC_OFF = LDSCTL_OFF + 320, LDS_BYTES = 147456;

#define XB_TMO      128
#define XB_XCNT(j)  (256  + 64 * (j))
#define XB_XSUB(j)  (1280 + 64 * (j))
#define XB_XGEN(j)  (2304 + 64 * (j))
#define XB_TOP      3328
#define XB_TOPGEN   3392
#define XCD_BAR_WORDS 3456
#define XB_SPIN_CAP (1u << 22)
__device__ __forceinline__ unsigned xb_ld(unsigned* p)              { return __hip_atomic_load(p, __ATOMIC_RELAXED, __HIP_MEMORY_SCOPE_AGENT); }
__device__ __forceinline__ unsigned xb_add(unsigned* p, unsigned v) { return __hip_atomic_fetch_add(p, v, __ATOMIC_RELAXED, __HIP_MEMORY_SCOPE_AGENT); }
__device__ __forceinline__ unsigned xb_xcc_id() { return (unsigned)__builtin_amdgcn_s_getreg((3 << 11) | 20) & 0xFu; }
#define XB_SPIN(cond, bar) do { unsigned _sp = 0; while (cond) { __builtin_amdgcn_s_sleep(1); \
    if ((++_sp & 255u) == 0u) { if (xb_ld(&(bar)[XB_TMO])) break; if (_sp > XB_SPIN_CAP) { atomicAdd(&(bar)[XB_TMO], 1u); break; } } } } while (0)
struct XcdBarrier { unsigned* bar; unsigned x; volatile LAS unsigned* st; };
__device__ __forceinline__ XcdBarrier xcd_barrier_post(unsigned* bar, volatile LAS unsigned* st) {
    XcdBarrier b; b.bar = bar; b.x = xb_xcc_id(); b.st = st;
    if (threadIdx.x == 0) (void)xb_add(&bar[XB_XCNT(b.x)], 1u);
    return b;
}
__device__ __forceinline__ void xcd_barrier_complete(unsigned* bar, unsigned x, unsigned& nloc, unsigned& nx) {
    const unsigned G = gridDim.x * gridDim.y * gridDim.z;
    unsigned sum, cnt, mine, sp = 0u;
    for (;;) {
        sum = 0u; cnt = 0u; mine = 0u;
#pragma unroll
        for (unsigned j = 0; j < 16; ++j) { const unsigned c = xb_ld(&bar[XB_XCNT(j)]); sum += c; cnt += (c > 0u) ? 1u : 0u; mine = (j == x) ? c : mine; }
        if (sum == G) break;
        __builtin_amdgcn_s_sleep(1);
        if ((++sp & 255u) == 0u) { if (xb_ld(&bar[XB_TMO])) break; if (sp > XB_SPIN_CAP) { atomicAdd(&bar[XB_TMO], 1u); break; } }
    }
    nloc = mine > 0u ? mine : 1u; nx = cnt > 0u ? cnt : 1u;
}
__device__ __forceinline__ void xcd_barrier(const XcdBarrier& b) {
    asm volatile("s_waitcnt vmcnt(0)" ::: "memory");
    __syncthreads();
    if (threadIdx.x == 0) {
        unsigned* bar = b.bar;
        __builtin_amdgcn_s_waitcnt(0);
        unsigned nloc = b.st[0], nx = b.st[1];
        if (nloc == 0u) { xcd_barrier_complete(bar, b.x, nloc, nx); b.st[0] = nloc; b.st[1] = nx; }
        const unsigned old = xb_add(&bar[XB_XSUB(b.x)], 1u);
        const unsigned gen = old / nloc;
        if (old + 1u == (gen + 1u) * nloc) {
            __builtin_amdgcn_fence(__ATOMIC_RELEASE, "agent");
            asm volatile("s_waitcnt vmcnt(0)" ::: "memory");
            const unsigned og = xb_add(&bar[XB_TOP], 1u);
            const unsigned tg = og / nx;
            if (og + 1u == (tg + 1u) * nx) xb_add(&bar[XB_TOPGEN], 1u);
            else XB_SPIN(xb_ld(&bar[XB_TOPGEN]) == tg, bar);
            __builtin_amdgcn_fence(__ATOMIC_ACQUIRE, "agent");
            xb_add(&bar[XB_XGEN(b.x)], 1u);
            asm volatile("s_waitcnt vmcnt(0)" ::: "memory");
        } else {
            XB_SPIN(xb_ld(&bar[XB_XGEN(b.x)]) == gen, bar);
            __builtin_amdgcn_fence(__ATOMIC_ACQUIRE, "agent");
            asm volatile("s_waitcnt vmcnt(0)" ::: "memory");
        }
    }
    __syncthreads();
}

constexpr int NWAVES = 8;
struct Args { const float* in[15]; float* out; unsigned char* ws; int ph_lo, ph_hi; };
struct Frame { LAS unsigned char* lds; int tid, lane, wave, vcu, G; };

__device__ __forceinline__ float wave_sum(float v) {
#pragma unroll
    for (int o = 1; o < 64; o <<= 1) v += __shfl_xor(v, o);
    return v;
}

__constant__ float c_invfreq[32] = {1.000000000e+00f, 7.498942614e-01f, 5.623413324e-01f, 4.216965139e-01f, 3.162277639e-01f, 2.371373773e-01f, 1.778279394e-01f, 1.333521307e-01f,
    1.000000015e-01f, 7.498941571e-02f, 5.623413250e-02f, 4.216965288e-02f, 3.162277490e-02f, 2.371373773e-02f, 1.778279431e-02f, 1.333521493e-02f,
    9.999999776e-03f, 7.498941850e-03f, 5.623413250e-03f, 4.216964822e-03f, 3.162277630e-03f, 2.371373586e-03f, 1.778279431e-03f, 1.333521446e-03f,
    1.000000047e-03f, 7.498942432e-04f, 5.623413017e-04f, 4.216965172e-04f, 3.162277571e-04f, 2.371373703e-04f, 1.778279402e-04f, 1.333521504e-04f};

__device__ __forceinline__ void p0_transpose_item(const float* W, int N, bf16_t* WT, int ldd, int koff, bool qkperm, LAS float* scr, int kb, int nb, int lane) {
    const int k0 = 64 * kb, n0 = 32 * nb;
    int nd = n0 + (lane & 31), nsrc = nd;
    if (qkperm) { const int dp = nd & 63; nsrc = (nd & ~63) + ((dp & 1) ? 32 + (dp >> 1) : (dp >> 1)); }
#pragma unroll 8
    for (int i = 0; i < 32; ++i) { const int kk = 2 * i + (lane >> 5); scr[kk * 33 + (lane & 31)] = W[(size_t)(k0 + kk) * N + nsrc]; }
    asm volatile("s_waitcnt lgkmcnt(0)" ::: "memory");
    const int c = lane & 7;
#pragma unroll
    for (int j = 0; j < 4; ++j) { const int n = (lane >> 3) + 8 * j; const LAS float* s = scr + (8 * c) * 33 + n;
        u32x4 o; o.x = cvtpk(s[0 * 33], s[1 * 33]); o.y = cvtpk(s[2 * 33], s[3 * 33]); o.z = cvtpk(s[4 * 33], s[5 * 33]); o.w = cvtpk(s[6 * 33], s[7 * 33]);
        *(u32x4*)(WT + (size_t)(n0 + n) * ldd + koff + k0 + 8 * c) = o; }
    asm volatile("s_waitcnt lgkmcnt(0)" ::: "memory");
}

__device__ __forceinline__ void p0_prologue(const Frame& F, const Args& a) {
    unsigned char* ws = a.ws;
    LAS float* scr = (LAS float*)(F.lds + F.wave * 16384);
    const int gw = F.vcu * NWAVES + F.wave, NGW = F.G * NWAVES;
    const float* w_in = a.in[2]; const float* w_ba = a.in[7]; const float* w_bg = a.in[8]; const float* w_out = a.in[9]; const float* w_mi = a.in[12]; const float* w_mo = a.in[13];
    constexpr int I_IN = (DM / 64) * (INW / 32), I_BA = (AOW / 64) * (DM / 32), I_BG = (GW / 64) * (DM / 32), I_OUT = (DM / 64) * (DM / 32), I_MI = (DM / 64) * (DFF / 32), I_MO = (DFF / 64) * (DM / 32);
    constexpr int NITEMS = I_IN + I_BA + I_BG + I_OUT + I_MI + I_MO;
    for (int it = gw; it < NITEMS; it += NGW) {
        int r = it;
        if (r < I_IN) { const int nblk = INW / 32, kb = r / nblk, nb = r % nblk; p0_transpose_item(w_in, INW, (bf16_t*)(ws + WS_WIN), DM, 0, nb < (2 * AW / 32), scr, kb, nb, F.lane); continue; } r -= I_IN;
        if (r < I_BA) { const int nblk = DM / 32, kb = r / nblk, nb = r % nblk; p0_transpose_item(w_ba, DM, (bf16_t*)(ws + WS_WCAT), AOW + GW, 0, false, scr, kb, nb, F.lane); continue; } r -= I_BA;
        if (r < I_BG) { const int nblk = DM / 32, kb = r / nblk, nb = r % nblk; p0_transpose_item(w_bg, DM, (bf16_t*)(ws + WS_WCAT), AOW + GW, AOW, false, scr, kb, nb, F.lane); continue; } r -= I_BG;
        if (r < I_OUT) { const int nblk = DM / 32, kb = r / nblk, nb = r % nblk; p0_transpose_item(w_out, DM, (bf16_t*)(ws + WS_WOUT), DM, 0, false, scr, kb, nb, F.lane); continue; } r -= I_OUT;
        if (r < I_MI) { const int nblk = DFF / 32, kb = r / nblk, nb = r % nblk; p0_transpose_item(w_mi, DFF, (bf16_t*)(ws + WS_WMI), DM, 0, false, scr, kb, nb, F.lane); continue; } r -= I_MI;
        { const int nblk = DM / 32, kb = r / nblk, nb = r % nblk; p0_transpose_item(w_mo, DM, (bf16_t*)(ws + WS_WMO), DFF, 0, false, scr, kb, nb, F.lane); }
    }
    const int gt = F.vcu * (NWAVES * 64) + F.tid, NGT = F.G * NWAVES * 64;
    { const float* wsp = a.in[3]; bf16_t* o = (bf16_t*)(ws + WS_WSP);
      for (int e = gt; e < 4 * 128 * 128 / 2; e += NGT) { const int i = (e >> 6) & 127, j = (e & 63) * 2; const f32x2 w = *(const f32x2*)(wsp + 2 * (size_t)e);
          *(unsigned*)(o + 2 * (size_t)e) = cvtpk(j <= i ? w.x : 0.f, (j + 1) <= i ? w.y : 0.f); } }
    { f32x2* T = (f32x2*)(ws + WS_ROPE);
      for (int e = gt; e < SEQ * 32; e += NGT) { const int s = e >> 5, i = e & 31; const float ang = (float)s * c_invfreq[i];
          double rev = (double)ang * 0.15915494309189535; rev -= __builtin_floor(rev); const float f = (float)rev;
          T[e] = (f32x2){__builtin_amdgcn_cosf(f), __builtin_amdgcn_sinf(f)}; } }
    { const float* x = a.in[0]; const float* gn = a.in[1]; bf16_t* XN = (bf16_t*)(ws + WS_XN);
      f32x4 gv[4];
#pragma unroll
      for (int j = 0; j < 4; ++j) gv[j] = *((const f32x4*)gn + F.lane + 64 * j);
      for (int m = gw; m < MROWS; m += NGW) {
          const f32x4* xr = (const f32x4*)(x + (size_t)m * DM) + F.lane; f32x4 v[4]; float s = 0.f;
#pragma unroll
          for (int j = 0; j < 4; ++j) { v[j] = xr[64 * j]; s += (v[j].x * v[j].x + v[j].y * v[j].y) + (v[j].z * v[j].z + v[j].w * v[j].w); }
          const float rs = 1.0f / sqrtf(wave_sum(s) * (1.f / DM) + EPS);
          u32x2* o8 = (u32x2*)(XN + (size_t)m * DM) + F.lane;
#pragma unroll
          for (int j = 0; j < 4; ++j) { const f32x4 t = v[j] * rs * gv[j]; o8[64 * j] = (u32x2){cvtpk(t.x, t.y), cvtpk(t.z, t.w)}; }
      } }
}

constexpr int KP = 72, VP = 408;
constexpr int ATT_KS = 0, ATT_VT = 384 * KP * 2;
__device__ __forceinline__ f32x4 mfma16(bf16x8 a, bf16x8 b, f32x4 c) { return __builtin_amdgcn_mfma_f32_16x16x32_bf16(a, b, c, 0, 0, 0); }
__device__ __forceinline__ void attn_phase(const Frame& F, const Args& a) {
    unsigned char* ws = a.ws;
    const bf16_t* Q = (const bf16_t*)(ws + WS_Q); const bf16_t* K = (const bf16_t*)(ws + WS_K); const bf16_t* V = (const bf16_t*)(ws + WS_V);
    bf16_t* OG = (bf16_t*)(ws + WS_OG); float* LSE = (float*)(ws + WS_LSE);
    LAS unsigned char* Ks = F.lds + ATT_KS; LAS unsigned char* Vt = F.lds + ATT_VT;
    const int l15 = F.lane & 15, g4 = F.lane >> 4;
    for (int du = F.vcu; du < BATCH * 12 * 32; du += F.G) {
        const int bh = du >> 5, idx = du & 31, b = bh / 12, h = bh % 12, grp = h >> 2;
        const int dl = grp * 2, d = 1 << dl, nper = (SEQ >> dl) >> 8;
        const int r = idx / nper, np = idx % nper;
        const size_t rowb = (size_t)b * SEQ; const int sub0 = 256 * np - 128;
#pragma unroll
        for (int it = 0; it < 6; ++it) { const int p = F.tid + 512 * it, key = p >> 3, ch = p & 7, sub = sub0 + key; u32x4 kv = {0u, 0u, 0u, 0u};
            if (sub >= 0) kv = *(const u32x4*)(K + (rowb + (size_t)sub * d + r) * AW + h * 64 + ch * 8);
            *(LAS u32x4*)(Ks + (key * KP + ch * 8) * 2) = kv; }
#pragma unroll
        for (int it = 0; it < 6; ++it) { const int p = F.tid + 512 * it, key = p % 384, ch = p / 384, sub = sub0 + key; u32x4 vv = {0u, 0u, 0u, 0u};
            if (sub >= 0) vv = *(const u32x4*)(V + (rowb + (size_t)sub * d + r) * AW + h * 64 + ch * 8);
            LAS unsigned short* vp = (LAS unsigned short*)(Vt + ((ch * 8) * VP + key) * 2);
            vp[0 * VP] = (unsigned short)(vv.x & 0xffffu); vp[1 * VP] = (unsigned short)(vv.x >> 16); vp[2 * VP] = (unsigned short)(vv.y & 0xffffu); vp[3 * VP] = (unsigned short)(vv.y >> 16);
            vp[4 * VP] = (unsigned short)(vv.z & 0xffffu); vp[5 * VP] = (unsigned short)(vv.z >> 16); vp[6 * VP] = (unsigned short)(vv.w & 0xffffu); vp[7 * VP] = (unsigned short)(vv.w >> 16); }
        for (int e = F.tid; e < 64 * 24; e += 512) { const int dd = e / 24, kk = 384 + e % 24; *(LAS unsigned short*)(Vt + (dd * VP + kk) * 2) = 0; }
        __syncthreads();
#pragma unroll 1
        for (int tt = 0; tt < 2; ++tt) {
            const int t = 2 * F.wave + tt;
            const size_t qtok = rowb + (size_t)(256 * np + 16 * t + l15) * d + r;
            bf16x8 qf[2];
#pragma unroll
            for (int ks = 0; ks < 2; ++ks) qf[ks] = *(const bf16x8*)(Q + qtok * AW + h * 64 + ks * 32 + g4 * 8);
            f32x4 s[9];
#pragma unroll
            for (int kt = 0; kt < 9; ++kt) { s[kt] = (f32x4){0.f, 0.f, 0.f, 0.f};
#pragma unroll
                for (int ks = 0; ks < 2; ++ks) { const bf16x8 kf = *(const LAS bf16x8*)(Ks + ((16 * (t + kt) + l15) * KP + ks * 32 + g4 * 8) * 2); s[kt] = mfma16(kf, qf[ks], s[kt]); } }
            const int qi = 16 * t + l15; float mx = -3.0e38f;
#pragma unroll
            for (int kt = 0; kt < 9; ++kt)
#pragma unroll
                for (int e = 0; e < 4; ++e) { const int j = 16 * (t + kt) + 4 * g4 + e; const bool ok = (j >= qi) && (j <= qi + 128) && (np > 0 || j >= 128);
                    s[kt][e] = ok ? s[kt][e] : -1.0e30f; mx = fmaxf(mx, s[kt][e]); }
            mx = fmaxf(mx, __shfl_xor(mx, 16)); mx = fmaxf(mx, __shfl_xor(mx, 32));
            float sum = 0.f;
#pragma unroll
            for (int kt = 0; kt < 9; ++kt)
#pragma unroll
                for (int e = 0; e < 4; ++e) { s[kt][e] = __builtin_amdgcn_exp2f(s[kt][e] - mx); sum += s[kt][e]; }
            sum += __shfl_xor(sum, 16); sum += __shfl_xor(sum, 32);
            bf16x8 pf[5];
#pragma unroll
            for (int s5 = 0; s5 < 5; ++s5) { u32x4 w; w.x = cvtpk(s[2 * s5][0], s[2 * s5][1]); w.y = cvtpk(s[2 * s5][2], s[2 * s5][3]);
                if (s5 < 4) { w.z = cvtpk(s[2 * s5 + 1][0], s[2 * s5 + 1][1]); w.w = cvtpk(s[2 * s5 + 1][2], s[2 * s5 + 1][3]); } else { w.z = 0u; w.w = 0u; }
                pf[s5] = __builtin_bit_cast(bf16x8, w); }
            const float inv = 1.0f / sum;
#pragma unroll
            for (int dt = 0; dt < 4; ++dt) { f32x4 o = {0.f, 0.f, 0.f, 0.f};
#pragma unroll
                for (int s5 = 0; s5 < 5; ++s5) { const LAS unsigned char* vb = Vt + ((16 * dt + l15) * VP + 16 * (t + 2 * s5) + 4 * g4) * 2;
                    const s16x4 lo = *(const LAS s16x4*)vb, hi = *(const LAS s16x4*)(vb + 32);
                    const bf16x8 vf = __builtin_shufflevector(lo, hi, 0, 1, 2, 3, 4, 5, 6, 7); o = mfma16(vf, pf[s5], o); }
                *(u32x2*)(OG + qtok * AW + h * 64 + 16 * dt + 4 * g4) = (u32x2){cvtpk(o[0] * inv, o[1] * inv), cvtpk(o[2] * inv, o[3] * inv)}; }
            if (g4 == 0) LSE[qtok * 12 + h] = mx + __builtin_amdgcn_logf(sum);
        }
        __syncthreads();
    }
}

constexpr int ZP = 136;
__device__ __forceinline__ void gmlp_phase(const Frame& F, const Args& a) {
    unsigned char* ws = a.ws;
    const bf16_t* U = (const bf16_t*)(ws + WS_U); const bf16_t* Z = (const bf16_t*)(ws + WS_Z); const f32x2* zst = (const f32x2*)(ws + WS_ZST);
    const bf16_t* Wsp = (const bf16_t*)(ws + WS_WSP); bf16_t* YC = (bf16_t*)(ws + WS_XN);
    const float* bsp = a.in[4]; const float* lng = a.in[5]; const float* lnb = a.in[6];
    LAS unsigned char* Zt = F.lds; LAS f32x2* st = (LAS f32x2*)(F.lds + 128 * ZP * 2);
    const int l15 = F.lane & 15, g4 = F.lane >> 4, w = F.wave;
    for (int un = F.vcu; un < (MROWS / 128) * 4; un += F.G) {
        const int c = un >> 2, grp = un & 3; const size_t tok0 = (size_t)c * 128;
        if (F.tid < 128) { const f32x2* p = zst + (tok0 + F.tid) * 8; float s = 0.f, q = 0.f;
#pragma unroll
            for (int e = 0; e < 8; ++e) { const f32x2 v = p[e]; s += v.x; q += v.y; }
            const float mean = s * (1.f / GW), var = fmaxf(q * (1.f / GW) - mean * mean, 0.f); st[F.tid] = (f32x2){mean, 1.0f / sqrtf(var + EPS)}; }
        __syncthreads();
#pragma unroll
        for (int it = 0; it < 4; ++it) { const int p = F.tid + 512 * it, j = p & 127, c8 = p >> 7;
            const u32x4 zv = *(const u32x4*)(Z + (tok0 + j) * GW + grp * 128 + c8 * 8);
            const f32x4 ga = *(const f32x4*)(lng + grp * 128 + c8 * 8), gb = *(const f32x4*)(lng + grp * 128 + c8 * 8 + 4);
            const f32x4 ba = *(const f32x4*)(lnb + grp * 128 + c8 * 8), bb = *(const f32x4*)(lnb + grp * 128 + c8 * 8 + 4);
            const f32x2 ms = st[j];
            float zz[8] = {bflo(zv.x), bfhi(zv.x), bflo(zv.y), bfhi(zv.y), bflo(zv.z), bfhi(zv.z), bflo(zv.w), bfhi(zv.w)};
            const float gg[8] = {ga[0], ga[1], ga[2], ga[3], gb[0], gb[1], gb[2], gb[3]}; const float bbv[8] = {ba[0], ba[1], ba[2], ba[3], bb[0], bb[1], bb[2], bb[3]};
            LAS unsigned short* zp = (LAS unsigned short*)(Zt + ((c8 * 8) * ZP + j) * 2);
#pragma unroll
            for (int e = 0; e < 8; ++e) { const float zn = (zz[e] - ms.x) * ms.y * gg[e] + bbv[e]; zp[e * ZP] = (unsigned short)(cvtpk(zn, 0.f) & 0xffffu); } }
        __syncthreads();
        {
            bf16x8 wf[4];
#pragma unroll
            for (int ks = 0; ks < 4; ++ks) if (ks <= (w >> 1)) wf[ks] = *(const bf16x8*)(Wsp + ((size_t)(grp * 128 + 16 * w + l15)) * 128 + ks * 32 + g4 * 8);
            const int i = 16 * w + l15; const size_t tok = tok0 + i; const float bi = bsp[grp * 128 + i];
#pragma unroll
            for (int mt = 0; mt < 8; ++mt) { f32x4 acc = {0.f, 0.f, 0.f, 0.f};
#pragma unroll
                for (int ks = 0; ks < 4; ++ks) if (ks <= (w >> 1)) { const bf16x8 zf = *(const LAS bf16x8*)(Zt + ((16 * mt + l15) * ZP + ks * 32 + g4 * 8) * 2); acc = mfma16(zf, wf[ks], acc); }
                const int ch = 16 * mt + 4 * g4;
                const u32x2 uv = *(const u32x2*)(U + tok * GW + grp * 128 + ch);
                const float o0 = bflo(uv.x) * (acc[0] + bi), o1 = bfhi(uv.x) * (acc[1] + bi), o2 = bflo(uv.y) * (acc[2] + bi), o3 = bfhi(uv.y) * (acc[3] + bi);
                *(u32x2*)(YC + tok * (AOW + GW) + AOW + grp * 128 + ch) = (u32x2){cvtpk(o0, o1), cvtpk(o2, o3)}; }
        }
        __syncthreads();
    }
}
__device__ __forceinline__ void combine_phase(const Frame& F, const Args& a) {
    unsigned char* ws = a.ws;
    const bf16_t* OG = (const bf16_t*)(ws + WS_OG); const float* LSE = (const float*)(ws + WS_LSE); bf16_t* YC = (bf16_t*)(ws + WS_XN);
    const int gt = F.vcu * (NWAVES * 64) + F.tid, NGT = F.G * NWAVES * 64;
    for (int it = gt; it < MROWS * 32; it += NGT) {
        const size_t tok = (size_t)(it >> 5); const int j = (it >> 3) & 3, c8 = it & 7;
        const float l0 = LSE[tok * 12 + j], l1 = LSE[tok * 12 + 4 + j], l2 = LSE[tok * 12 + 8 + j];
        const float m = fmaxf(l0, fmaxf(l1, l2));
        float w0 = __builtin_amdgcn_exp2f(l0 - m), w1 = __builtin_amdgcn_exp2f(l1 - m), w2 = __builtin_amdgcn_exp2f(l2 - m);
        const float inv = 1.0f / (w0 + w1 + w2); w0 *= inv; w1 *= inv; w2 *= inv;
        const u32x4 a0 = *(const u32x4*)(OG + tok * AW + (j) * 64 + c8 * 8), a1 = *(const u32x4*)(OG + tok * AW + (4 + j) * 64 + c8 * 8), a2 = *(const u32x4*)(OG + tok * AW + (8 + j) * 64 + c8 * 8);
        u32x4 o;
        o.x = cvtpk(w0 * bflo(a0.x) + w1 * bflo(a1.x) + w2 * bflo(a2.x), w0 * bfhi(a0.x) + w1 * bfhi(a1.x) + w2 * bfhi(a2.x));
        o.y = cvtpk(w0 * bflo(a0.y) + w1 * bflo(a1.y) + w2 * bflo(a2.y), w0 * bfhi(a0.y) + w1 * bfhi(a1.y) + w2 * bfhi(a2.y));
        o.z = cvtpk(w0 * bflo(a0.z) + w1 * bflo(a1.z) + w2 * bflo(a2.z), w0 * bfhi(a0.z) + w1 * bfhi(a1.z) + w2 * bfhi(a2.z));
        o.w = cvtpk(w0 * bflo(a0.w) + w1 * bflo(a1.w) + w2 * bflo(a2.w), w0 * bfhi(a0.w) + w1 * bfhi(a1.w) + w2 * bfhi(a2.w));
        *(u32x4*)(YC + tok * (AOW + GW) + j * 64 + c8 * 8) = o;
    }
}
__device__ __forceinline__ void rowpass1(const Frame& F, const Args& a) {
    unsigned char* ws = a.ws;
    const float* x = a.in[0]; const float* g1 = a.in[10]; const float* g2 = a.in[11];
    const bf16_t* Y = (const bf16_t*)(ws + WS_Y); const float* ss = (const float*)(ws + WS_SS1); bf16_t* XN2 = (bf16_t*)(ws + WS_XN); float* out = a.out;
    const int gw = F.vcu * NWAVES + F.wave, NGW = F.G * NWAVES;
    f32x4 g1v[4], g2v[4];
#pragma unroll
    for (int j = 0; j < 4; ++j) { g1v[j] = *((const f32x4*)g1 + F.lane + 64 * j); g2v[j] = *((const f32x4*)g2 + F.lane + 64 * j); }
    for (int m = gw; m < MROWS; m += NGW) {
        const float part = (F.lane < 16) ? ss[(size_t)m * 16 + F.lane] : 0.f;
        const float rs1 = 1.0f / sqrtf(wave_sum(part) * (1.f / DM) + EPS);
        const f32x4* xr = (const f32x4*)(x + (size_t)m * DM) + F.lane; const u32x2* yr = (const u32x2*)(Y + (size_t)m * DM) + F.lane;
        f32x4 v[4]; float s = 0.f;
#pragma unroll
        for (int j = 0; j < 4; ++j) { const f32x4 xv = xr[64 * j]; const u32x2 yv = yr[64 * j]; const f32x4 yf = {bflo(yv.x), bfhi(yv.x), bflo(yv.y), bfhi(yv.y)};
            v[j] = xv + yf * rs1 * g1v[j]; s += (v[j].x * v[j].x + v[j].y * v[j].y) + (v[j].z * v[j].z + v[j].w * v[j].w); }
        const float rs2 = 1.0f / sqrtf(wave_sum(s) * (1.f / DM) + EPS);
        f32x4* orow = (f32x4*)(out + (size_t)m * DM) + F.lane; u32x2* o8 = (u32x2*)(XN2 + (size_t)m * DM) + F.lane;
#pragma unroll
        for (int j = 0; j < 4; ++j) { orow[64 * j] = v[j]; const f32x4 t = v[j] * rs2 * g2v[j]; o8[64 * j] = (u32x2){cvtpk(t.x, t.y), cvtpk(t.z, t.w)}; }
    }
}
__device__ __forceinline__ void rowpass2(const Frame& F, const Args& a) {
    unsigned char* ws = a.ws;
    const float* g4v_ = a.in[14]; const bf16_t* Y2 = (const bf16_t*)(ws + WS_XN); const float* ss = (const float*)(ws + WS_SS2); float* out = a.out;
    const int gw = F.vcu * NWAVES + F.wave, NGW = F.G * NWAVES;
    f32x4 gv[4];
#pragma unroll
    for (int j = 0; j < 4; ++j) gv[j] = *((const f32x4*)g4v_ + F.lane + 64 * j);
    for (int m = gw; m < MROWS; m += NGW) {
        const float part = (F.lane < 16) ? ss[(size_t)m * 16 + F.lane] : 0.f;
        const float rs = 1.0f / sqrtf(wave_sum(part) * (1.f / DM) + EPS);
        f32x4* orow = (f32x4*)(out + (size_t)m * DM) + F.lane; const u32x2* yr = (const u32x2*)(Y2 + (size_t)m * DM) + F.lane;
#pragma unroll
        for (int j = 0; j < 4; ++j) { const f32x4 xv = orow[64 * j]; const u32x2 yv = yr[64 * j]; const f32x4 yf = {bflo(yv.x), bfhi(yv.x), bflo(yv.y), bfhi(yv.y)};
            orow[64 * j] = xv + yf * rs * gv[j]; }
    }
}

constexpr int N_PHASES = 10;
__global__ void __launch_bounds__(NWAVES * 64, 2) fwd_megakernel(Args args) {
    extern __shared__ __attribute__((aligned(16))) unsigned char lds_raw[];
    Frame F;
    F.lds = (LAS unsigned char*)lds_raw;
    F.tid = threadIdx.x; F.lane = F.tid & 63; F.wave = __builtin_amdgcn_readfirstlane(F.tid >> 6);
    F.G = gridDim.x; { const int bx = blockIdx.x; F.vcu = (F.G % 8 == 0) ? (bx % 8) * (F.G / 8) + bx / 8 : bx; }
    unsigned char* ws = args.ws;
    for (int u = F.tid; u < (LDS_BYTES - LDSCTL_OFF) / 4; u += NWAVES * 64) ((LAS unsigned*)(F.lds + LDSCTL_OFF))[u] = 0u;
    __syncthreads();
    const int lo = args.ph_lo, hi = args.ph_hi;
    const bool multi = (hi - lo) > 1;
    XcdBarrier bar; bar.bar = (unsigned*)(ws + WS_CTL) + CW_BAR; bar.x = 0; bar.st = nullptr;
    if (multi) bar = xcd_barrier_post((unsigned*)(ws + WS_CTL) + CW_BAR, (volatile LAS unsigned*)(F.lds + MISC_OFF) + 8);
#define IN(k) (lo <= (k) && (k) < hi)
#define SEAM(k) do { if (IN(k) && IN((k) + 1)) xcd_barrier(bar); } while (0)
    if (IN(0)) { p0_prologue(F, args); SEAM(0); }
    if (IN(1)) {
        pg8::Gemm g{(bf16_t*)(ws + WS_XN), nullptr, (bf16_t*)(ws + WS_WIN), nullptr, DM / 64, 0, DM, DM};
        pg8::StaticOrder S; S.init(MROWS, INW, F.G, (int)blockIdx.x, 1);
        pg8::EpiP1 E{(bf16_t*)(ws + WS_Q), (bf16_t*)(ws + WS_K), (bf16_t*)(ws + WS_V), (bf16_t*)(ws + WS_U), (bf16_t*)(ws + WS_Z), (bf16_t*)(ws + WS_GA), (bf16_t*)(ws + WS_GB), (f32x2*)(ws + WS_ZST), (const float*)(ws + WS_ROPE)};
        pg8::gemm_phase<pg8::EpiP1, true>(F.lds, g, S, E);
        SEAM(1);
    }
    if (IN(2)) { attn_phase(F, args); SEAM(2); }
    if (IN(3)) { gmlp_phase(F, args); combine_phase(F, args); SEAM(3); }
    if (IN(4)) {
        const bf16_t* YC = (const bf16_t*)(ws + WS_XN); const bf16_t* WC = (const bf16_t*)(ws + WS_WCAT);
        pg8::Gemm g{YC, YC + AOW, WC, WC + AOW, AOW / 64, GW / 64, AOW + GW, AOW + GW};
        pg8::StaticOrder S; S.init(MROWS, DM, F.G, (int)blockIdx.x, 2);
        pg8::EpiMerge E{(const bf16_t*)(ws + WS_GA), (const bf16_t*)(ws + WS_GB), (bf16_t*)(ws + WS_MG)};
        pg8::gemm_phase<pg8::EpiMerge, true>(F.lds, g, S, E);
        SEAM(4);
    }
    if (IN(5)) {
        pg8::Gemm g{(bf16_t*)(ws + WS_MG), nullptr, (bf16_t*)(ws + WS_WOUT), nullptr, DM / 64, 0, DM, DM};
        pg8::StaticOrder S; S.init(MROWS, DM, F.G, (int)blockIdx.x, 1);
        pg8::EpiYss E{(bf16_t*)(ws + WS_Y), (float*)(ws + WS_SS1)};
        pg8::gemm_phase<pg8::EpiYss, true>(F.lds, g, S, E);
        SEAM(5);
    }
    if (IN(6)) { rowpass1(F, args); SEAM(6); }
    if (IN(7)) {
        pg8::Gemm g{(bf16_t*)(ws + WS_XN), nullptr, (bf16_t*)(ws + WS_WMI), nullptr, DM / 64, 0, DM, DM};
        pg8::StaticOrder S; S.init(MROWS, DFF, F.G, (int)blockIdx.x, 1);
        pg8::EpiRelu2 E{(bf16_t*)(ws + WS_H)};
        pg8::gemm_phase<pg8::EpiRelu2, true>(F.lds, g, S, E);
        SEAM(7);
    }
    if (IN(8)) {
        pg8::Gemm g{(bf16_t*)(ws + WS_H), nullptr, (bf16_t*)(ws + WS_WMO), nullptr, DFF / 64, 0, DFF, DFF};
        pg8::StaticOrder S; S.init(MROWS, DM, F.G, (int)blockIdx.x, 1);
        pg8::EpiYss E{(bf16_t*)(ws + WS_XN), (float*)(ws + WS_SS2)};
        pg8::gemm_phase<pg8::EpiYss, true>(F.lds, g, S, E);
        SEAM(8);
    }
    if (IN(9)) { rowpass2(F, args); }
#undef IN
#undef SEAM
}

#ifndef MK_PER_PHASE
#define MK_PER_PHASE 0
#endif
extern "C" void kernel_launch(void* const* d_in, const int* in_sizes, int n_in, void* d_out, int out_size, void* d_ws, size_t ws_size, hipStream_t stream) {
    static int grid = 0;
    if (grid == 0) {
        if (n_in != 15 || in_sizes[0] != MROWS * DM || out_size != MROWS * DM || ws_size < WS_END) { fprintf(stderr, "kernel_launch: unexpected shapes (n_in %d, in0 %d, out %d, ws %zu)\n", n_in, n_in > 0 ? in_sizes[0] : -1, out_size, ws_size); grid = -1; return; }
        int dev = 0, cus = 0, per_cu = 0;
        if (hipGetDevice(&dev) != hipSuccess || hipDeviceGetAttribute(&cus, hipDeviceAttributeMultiprocessorCount, dev) != hipSuccess) { grid = -1; return; }
        if (hipFuncSetAttribute((const void*)fwd_megakernel, hipFuncAttributeMaxDynamicSharedMemorySize, LDS_BYTES) != hipSuccess) { fprintf(stderr, "kernel_launch: hipFuncSetAttribute failed\n"); grid = -1; return; }
        if (hipOccupancyMaxActiveBlocksPerMultiprocessor(&per_cu, (const void*)fwd_megakernel, NWAVES * 64, LDS_BYTES) != hipSuccess || per_cu < 1) { fprintf(stderr, "kernel_launch: occupancy query says %d blocks per CU\n", per_cu); }
        (void)hipGetLastError();
        grid = cus;
    }
    if (grid < 0) return;
    (void)hipMemsetAsync((char*)d_ws + WS_CTL, 0, CTL_ZERO_BYTES, stream);
    Args a{};
    for (int i = 0; i < 15; ++i) a.in[i] = (const float*)d_in[i];
    a.out = (float*)d_out; a.ws = (unsigned char*)d_ws;
#if MK_PER_PHASE
    for (int p = 0; p < N_PHASES; ++p) { a.ph_lo = p; a.ph_hi = p + 1; hipLaunchKernelGGL(fwd_megakernel, dim3(grid), dim3(NWAVES * 64), LDS_BYTES, stream, a); }
#else
    a.ph_lo = 0; a.ph_hi = N_PHASES; hipLaunchKernelGGL(fwd_megakernel, dim3(grid), dim3(NWAVES * 64), LDS_BYTES, stream, a);
#endif
}
```

```cpp
#include <hip/hip_runtime.h>
#include <cstdio>
#include <cstdint>

#define LAS __attribute__((address_space(3)))
typedef unsigned short bf16_t;
typedef short bf16x8 __attribute__((ext_vector_type(8)));
typedef short s16x4 __attribute__((ext_vector_type(4)));
typedef float f32x4 __attribute__((ext_vector_type(4)));
typedef float f32x2 __attribute__((ext_vector_type(2)));
typedef unsigned u32x4 __attribute__((ext_vector_type(4)));
typedef unsigned u32x2 __attribute__((ext_vector_type(2)));
typedef __bf16 bf16x2_t __attribute__((ext_vector_type(2)));

constexpr int BATCH = 8, SEQ = 8192, DM = 1024, MROWS = BATCH * SEQ;
constexpr int AW = 768, AOW = 256, GW = 512, DFF = 4096, INW = 5376;
constexpr float EPS = 1e-6f;
constexpr float QSCALE = 0.125f * 1.4426950408889634f;

__device__ __forceinline__ unsigned cvtpk(float lo, float hi) { f32x2 v = {lo, hi}; bf16x2_t b = __builtin_convertvector(v, bf16x2_t); return __builtin_bit_cast(unsigned, b); }
__device__ __forceinline__ size_t hrow(int b, int t, int h) { const int dl = (h >> 2) * 2; return ((size_t)(b * 12 + h) * SEQ + (size_t)((t & ((1 << dl) - 1)) * (SEQ >> dl) + (t >> dl))); }
__device__ __forceinline__ float bflo(unsigned u) { return __uint_as_float(u << 16); }
__device__ __forceinline__ float bfhi(unsigned u) { return __uint_as_float(u & 0xffff0000u); }
__device__ __forceinline__ float gelu_tanh(float x) {
    const float t = x * (1.5957691216057308f + 0.07135481627159498f * x * x);
    return x * __builtin_amdgcn_rcpf(1.0f + __builtin_amdgcn_exp2f(-1.4426950408889634f * t));
}
__device__ __forceinline__ float sigmoidf_(float x) { return __builtin_amdgcn_rcpf(1.0f + __builtin_amdgcn_exp2f(-1.4426950408889634f * x)); }

namespace pg8 {
constexpr int BM = 256, BK = 64, HALF = 128, HTB = HALF * BK * 2, STAGE_BYTES = 8 * HTB, NXCD = 8, WGM = 8;
__host__ __device__ __forceinline__ int lds_byte(int r, int c) { const int st = (r >> 4) * 2 + (c >> 5), rr = r & 15, cc = c & 31, ob = rr * 64 + cc * 2; return st * 1024 + (ob ^ (((ob >> 9) & 1) << 5)); }
__host__ __device__ __forceinline__ void stage_rc(int b, int& R, int& C) { const int st = b / 1024, sb = b % 1024, swz = sb ^ (((sb >> 9) & 1) << 5); R = (st >> 1) * 16 + swz / 64; C = (st & 1) * 32 + (swz % 64) / 2; }
__host__ __device__ __forceinline__ int perm32(int rho) { const int n = rho >> 4, i = rho & 15; return 8 * (i >> 2) + 4 * n + (i & 3); }

struct Unit { int pm, pn, kind; };
struct Gemm { const bf16_t* A0; const bf16_t* A1; const bf16_t* B0; const bf16_t* B1; int nt0, nt1, lda, ldb; };

struct StaticOrder {
    int nM, nN, nwg, G, c, reps;
    __device__ void init(int M, int N, int G_, int c_, int reps_) { nM = M / BM; nN = N / BM; nwg = nM * nN; G = G_; c = c_; reps = reps_; }
    __device__ bool next(int i, Unit& u) const {
        const int it = (reps == 2) ? (i >> 1) : i; u.kind = (reps == 2) ? (i & 1) : 0;
        const long L = (long)it * G + c; if (L >= nwg) return false;
        int wgid = (int)L; { const int q = nwg / NXCD, r = nwg % NXCD, xcd = wgid % NXCD, off = wgid / NXCD; wgid = (xcd < r ? xcd * (q + 1) : r * (q + 1) + (xcd - r) * q) + off; }
        const int nig = WGM * nN, gid = wgid / nig, fm = gid * WGM, gsz = (nM - fm) < WGM ? (nM - fm) : WGM;
        u.pm = fm + ((wgid % nig) % gsz); u.pn = (wgid % nig) / gsz; return true;
    }
};

template <class Epi, bool ALIGN_EPI>
__device__ __forceinline__ void gemm_phase(LAS unsigned char* lds, const Gemm g, const StaticOrder& S, const Epi& E) {
    const int tid = threadIdx.x, wid = __builtin_amdgcn_readfirstlane(tid >> 6), lane = tid & 63, wr = wid >> 2, wc = wid & 3, fr = lane & 15, fq = lane >> 4;
    unsigned voffA[2], voffB[2];
#pragma unroll
    for (int i = 0; i < 2; ++i) { int R, C; stage_rc(tid * 16 + i * 8192, R, C); const int Rb = (R & ~31) + perm32(R & 31);
        voffA[i] = (unsigned)(R * g.lda + C) * 2u; voffB[i] = (unsigned)(Rb * g.ldb + C) * 2u; }
    const size_t kstep = (size_t)(BK * 2);
    const size_t hstepA = (size_t)HALF * g.lda * 2, hstepB = (size_t)HALF * g.ldb * 2;
    const size_t tstepA = 2 * hstepA, tstepB = 2 * hstepB;
    const unsigned ldsw = (unsigned)wid * 1024u;
    const int aoff = lds_byte(wr * 64 + fr, fq * 8), boff = lds_byte(wc * 32 + fr, fq * 8);
#define PG8_SA(b, h) (((b) * 2 + (h)) * HTB)
#define PG8_SB(b, h) ((4 + (b) * 2 + (h)) * HTB)
#define PG8_STAGE(bufoff, gbase, voff) do { _Pragma("unroll") for (int _i = 0; _i < 2; ++_i) \
        __builtin_amdgcn_global_load_lds((const unsigned*)((const char*)(gbase) + (voff)[_i]), (LAS unsigned*)(lds + (bufoff) + ldsw + _i * 8192), 16, 0, 0); } while (0)
#define PG8_LDA(dst, b, h) do { _Pragma("unroll") for (int m = 0; m < 4; ++m) _Pragma("unroll") for (int k = 0; k < 2; ++k) dst[m][k] = *(const LAS bf16x8*)(lds + PG8_SA(b, h) + aoff + m * 2048 + k * 1024); } while (0)
#define PG8_LDB(dst, b, h) do { _Pragma("unroll") for (int n = 0; n < 2; ++n) _Pragma("unroll") for (int k = 0; k < 2; ++k) dst[n][k] = *(const LAS bf16x8*)(lds + PG8_SB(b, h) + boff + n * 2048 + k * 1024); } while (0)
#define PG8_MMA(ai, bj, At, Bt) do { __builtin_amdgcn_s_setprio(1); _Pragma("unroll") for (int m = 0; m < 4; ++m) _Pragma("unroll") for (int n = 0; n < 2; ++n) _Pragma("unroll") for (int k = 0; k < 2; ++k) \
        acc[ai][bj][m][n] = __builtin_amdgcn_mfma_f32_16x16x32_bf16(Bt[n][k], At[m][k], acc[ai][bj][m][n], 0, 0, 0); __builtin_amdgcn_s_setprio(0); } while (0)
#define PG8_WAIT_V(n) asm volatile("s_waitcnt vmcnt(" #n ")" ::: "memory")
#define PG8_WAIT_L(n) asm volatile("s_waitcnt lgkmcnt(" #n ")" ::: "memory")
#define PG8_BAR __builtin_amdgcn_s_barrier()
#define PG8_SCHED __builtin_amdgcn_sched_barrier(0)
    Unit cur, nxt; int ui = 0;
    if (!S.next(0, cur)) return;
#ifdef STAGGER_TICKS
    { const unsigned long long t0_ = __builtin_amdgcn_s_memrealtime(); const unsigned long long dl_ = (unsigned long long)(((unsigned)blockIdx.x >> 3) & 3u) * STAGGER_TICKS;
      while (__builtin_amdgcn_s_memrealtime() - t0_ < dl_) __builtin_amdgcn_s_sleep(8); }
#endif
    f32x4 acc[2][2][4][2];
#pragma unroll
    for (int a = 0; a < 2; ++a)
#pragma unroll
        for (int b = 0; b < 2; ++b)
#pragma unroll
            for (int m = 0; m < 4; ++m)
#pragma unroll
                for (int n = 0; n < 2; ++n) acc[a][b][m][n] = (f32x4){0.f, 0.f, 0.f, 0.f};
    bf16x8 At[4][2], B0[2][2], B1[2][2];
    const char* cA = (const char*)(cur.kind ? g.A1 : g.A0) + (size_t)cur.pm * tstepA; const char* cB = (const char*)(cur.kind ? g.B1 : g.B0) + (size_t)cur.pn * tstepB;
    int nt = cur.kind ? g.nt1 : g.nt0;
    PG8_STAGE(PG8_SB(0, 0), cB, voffB); PG8_STAGE(PG8_SB(0, 1), cB + hstepB, voffB); PG8_STAGE(PG8_SA(0, 0), cA, voffA); PG8_STAGE(PG8_SA(0, 1), cA + hstepA, voffA);
    if (wr == 1) PG8_BAR;
    PG8_WAIT_V(2); PG8_BAR;
    PG8_STAGE(PG8_SB(1, 0), cB + kstep, voffB); PG8_STAGE(PG8_SA(1, 0), cA + kstep, voffA); PG8_STAGE(PG8_SB(1, 1), cB + hstepB + kstep, voffB);
    PG8_WAIT_V(6); PG8_BAR;
    for (;;) {
        const bool has_next = S.next(ui + 1, nxt);
        const char* nA = has_next ? (const char*)(nxt.kind ? g.A1 : g.A0) + (size_t)nxt.pm * tstepA : cA; const char* nB = has_next ? (const char*)(nxt.kind ? g.B1 : g.B0) + (size_t)nxt.pn * tstepB : cB;
#ifndef KREP
#define KREP 1
#endif
        for (int krep_ = 0; krep_ < KREP; ++krep_)
        for (int t = 0; t < nt; t += 2) {
            const bool lastt_ = (t == nt - 2), last = lastt_ && (krep_ == KREP - 1);
            const char* a1 = cA + (size_t)(t + 1) * kstep;
            const char* a2 = last ? nA : (lastt_ ? cA : cA + (size_t)(t + 2) * kstep); const char* b2 = last ? nB : (lastt_ ? cB : cB + (size_t)(t + 2) * kstep);
            const char* a3 = a2 + kstep; const char* b3 = b2 + kstep;
            PG8_LDB(B0, 0, 0); PG8_LDB(B1, 0, 1); PG8_SCHED; PG8_LDA(At, 0, 0); PG8_STAGE(PG8_SA(1, 1), a1 + hstepA, voffA);
            PG8_WAIT_V(8); PG8_WAIT_L(0); PG8_BAR; PG8_MMA(0, 0, At, B0); PG8_MMA(0, 1, At, B1); PG8_BAR; PG8_SCHED;
            PG8_LDA(At, 0, 1); PG8_STAGE(PG8_SB(0, 0), b2, voffB); PG8_STAGE(PG8_SB(0, 1), b2 + hstepB, voffB); PG8_STAGE(PG8_SA(0, 0), a2, voffA);
            PG8_WAIT_V(8); PG8_WAIT_L(0); PG8_BAR; PG8_MMA(1, 0, At, B0); PG8_MMA(1, 1, At, B1); PG8_BAR; PG8_SCHED;
            PG8_LDB(B0, 1, 0); PG8_LDB(B1, 1, 1); PG8_SCHED; PG8_LDA(At, 1, 0); PG8_STAGE(PG8_SA(0, 1), a2 + hstepA, voffA);
            PG8_WAIT_V(8); PG8_WAIT_L(0); PG8_BAR; PG8_MMA(0, 0, At, B0); PG8_MMA(0, 1, At, B1); PG8_BAR; PG8_SCHED;
            PG8_LDA(At, 1, 1); PG8_STAGE(PG8_SB(1, 0), b3, voffB); PG8_STAGE(PG8_SB(1, 1), b3 + hstepB, voffB); PG8_STAGE(PG8_SA(1, 0), a3, voffA);
            PG8_WAIT_V(8); PG8_WAIT_L(0); PG8_BAR; PG8_MMA(1, 0, At, B0); PG8_MMA(1, 1, At, B1); PG8_BAR; PG8_SCHED;
        }
        if constexpr (ALIGN_EPI) { if (wr == 0) PG8_BAR; }
        if (KREP > 1) {
#pragma unroll
            for (int a = 0; a < 2; ++a)
#pragma unroll
                for (int b = 0; b < 2; ++b)
#pragma unroll
                    for (int m = 0; m < 4; ++m)
#pragma unroll
                        for (int n = 0; n < 2; ++n) acc[a][b][m][n] *= (1.0f / KREP);
        }
        E(acc, cur, wr, wc, fr, fq);
        if (!has_next) break;
#pragma unroll
        for (int a = 0; a < 2; ++a)
#pragma unroll
            for (int b = 0; b < 2; ++b)
#pragma unroll
                for (int m = 0; m < 4; ++m)
#pragma unroll
                    for (int n = 0; n < 2; ++n) acc[a][b][m][n] = (f32x4){0.f, 0.f, 0.f, 0.f};
        cur = nxt; cA = nA; cB = nB; nt = cur.kind ? g.nt1 : g.nt0; ++ui;
        if constexpr (ALIGN_EPI) { if (wr == 1) PG8_BAR; }
    }
    PG8_WAIT_V(0);
    if constexpr (!ALIGN_EPI) { if (wr == 0) PG8_BAR; }
    PG8_BAR;
#undef PG8_SA
#undef PG8_SB
#undef PG8_STAGE
#undef PG8_LDA
#undef PG8_LDB
#undef PG8_MMA
#undef PG8_WAIT_V
#undef PG8_WAIT_L
#undef PG8_BAR
#undef PG8_SCHED
}

#define EPI_ROWS_BEGIN  _Pragma("unroll") for (int ai = 0; ai < 2; ++ai) _Pragma("unroll") for (int m = 0; m < 4; ++m) { const int r = u.pm * BM + ai * HALF + wr * 64 + m * 16 + fr; _Pragma("unroll") for (int bj = 0; bj < 2; ++bj) { \
        const f32x4 v0 = acc[ai][bj][m][0], v1 = acc[ai][bj][m][1]; const int c0 = u.pn * BM + bj * HALF + wc * 32 + fq * 8; (void)r; (void)c0;
#define EPI_ROWS_END } }
__device__ __forceinline__ u32x4 pack8(f32x4 a, f32x4 b) { u32x4 w; w.x = cvtpk(a[0], a[1]); w.y = cvtpk(a[2], a[3]); w.z = cvtpk(b[0], b[1]); w.w = cvtpk(b[2], b[3]); return w; }

struct EpiP1 {
    bf16_t *Q, *K, *V, *U, *Z, *GA, *GB; f32x2* zst; const float* rope;
    __device__ __forceinline__ void operator()(const f32x4 (&acc)[2][2][4][2], const Unit& u, int wr, int wc, int fr, int fq) const {
        const int pn = u.pn;
        if (pn < 6) {
            bf16_t* O = pn < 3 ? Q : K; const int cb = pn < 3 ? 0 : AW; const float sc = pn < 3 ? QSCALE : 1.0f;
            const int i0 = (wc & 1) * 16 + fq * 4;
            EPI_ROWS_BEGIN
                const float* tp = rope + ((size_t)(r & (SEQ - 1)) * 32 + i0) * 2;
                const f32x4 t0 = *(const f32x4*)tp, t1 = *(const f32x4*)(tp + 4);
                f32x4 o0, o1;
                o0[0] = (v0[0] * t0[0] - v0[1] * t0[1]) * sc; o0[1] = (v0[1] * t0[0] + v0[0] * t0[1]) * sc;
                o0[2] = (v0[2] * t0[2] - v0[3] * t0[3]) * sc; o0[3] = (v0[3] * t0[2] + v0[2] * t0[3]) * sc;
                o1[0] = (v1[0] * t1[0] - v1[1] * t1[1]) * sc; o1[1] = (v1[1] * t1[0] + v1[0] * t1[1]) * sc;
                o1[2] = (v1[2] * t1[2] - v1[3] * t1[3]) * sc; o1[3] = (v1[3] * t1[2] + v1[2] * t1[3]) * sc;
                *(u32x4*)(O + hrow(r >> 13, r & (SEQ - 1), (c0 - cb) >> 6) * 64 + ((c0 - cb) & 63)) = pack8(o0, o1);
            EPI_ROWS_END
        } else if (pn < 9) {
            EPI_ROWS_BEGIN
                *(u32x4*)(V + hrow(r >> 13, r & (SEQ - 1), (c0 - 2 * AW) >> 6) * 64 + ((c0 - 2 * AW) & 63)) = pack8(v0, v1);
            EPI_ROWS_END
        } else if (pn < 11) {
            EPI_ROWS_BEGIN
                f32x4 o0, o1;
#pragma unroll
                for (int e = 0; e < 4; ++e) { o0[e] = gelu_tanh(v0[e]); o1[e] = gelu_tanh(v1[e]); }
                *(u32x4*)(U + (size_t)r * GW + (c0 - 3 * AW)) = pack8(o0, o1);
            EPI_ROWS_END
        } else if (pn < 13) {
#pragma unroll
            for (int ai = 0; ai < 2; ++ai)
#pragma unroll
                for (int m = 0; m < 4; ++m) { const int r = u.pm * BM + ai * HALF + wr * 64 + m * 16 + fr; float s = 0.f, q = 0.f;
#pragma unroll
                    for (int bj = 0; bj < 2; ++bj) { const f32x4 v0 = acc[ai][bj][m][0], v1 = acc[ai][bj][m][1]; const int c0 = u.pn * BM + bj * HALF + wc * 32 + fq * 8;
                        f32x4 o0, o1;
#pragma unroll
                        for (int e = 0; e < 4; ++e) { o0[e] = gelu_tanh(v0[e]); o1[e] = gelu_tanh(v1[e]); s += o0[e] + o1[e]; q += o0[e] * o0[e] + o1[e] * o1[e]; }
                        *(u32x4*)(Z + (size_t)r * GW + (c0 - 3 * AW - GW)) = pack8(o0, o1); }
                    s += __shfl_xor(s, 16); s += __shfl_xor(s, 32); q += __shfl_xor(q, 16); q += __shfl_xor(q, 32);
                    if (fq == 0) zst[(size_t)r * 8 + (pn - 11) * 4 + wc] = (f32x2){s, q}; }
        } else {
            bf16_t* O = pn < 17 ? GA : GB; const int cb = pn < 17 ? (3 * AW + 2 * GW) : (3 * AW + 2 * GW + DM);
            EPI_ROWS_BEGIN
                f32x4 o0, o1;
#pragma unroll
                for (int e = 0; e < 4; ++e) { o0[e] = sigmoidf_(v0[e]); o1[e] = sigmoidf_(v1[e]); }
                *(u32x4*)(O + (size_t)r * DM + (c0 - cb)) = pack8(o0, o1);
            EPI_ROWS_END
        }
    }
};
struct EpiMerge {
    const bf16_t *GA, *GB; bf16_t* MG;
    __device__ __forceinline__ void operator()(const f32x4 (&acc)[2][2][4][2], const Unit& u, int wr, int wc, int fr, int fq) const {
        if (u.kind == 0) {
            EPI_ROWS_BEGIN
                const u32x4 gw = *(const u32x4*)(GA + (size_t)r * DM + c0);
                f32x4 o0, o1; o0[0] = v0[0] * bflo(gw.x); o0[1] = v0[1] * bfhi(gw.x); o0[2] = v0[2] * bflo(gw.y); o0[3] = v0[3] * bfhi(gw.y);
                o1[0] = v1[0] * bflo(gw.z); o1[1] = v1[1] * bfhi(gw.z); o1[2] = v1[2] * bflo(gw.w); o1[3] = v1[3] * bfhi(gw.w);
                *(u32x4*)(MG + (size_t)r * DM + c0) = pack8(o0, o1);
            EPI_ROWS_END
        } else {
            EPI_ROWS_BEGIN
                const u32x4 gw = *(const u32x4*)(GB + (size_t)r * DM + c0); const u32x4 pw = *(const u32x4*)(MG + (size_t)r * DM + c0);
                f32x4 o0, o1; o0[0] = bflo(pw.x) + v0[0] * bflo(gw.x); o0[1] = bfhi(pw.x) + v0[1] * bfhi(gw.x); o0[2] = bflo(pw.y) + v0[2] * bflo(gw.y); o0[3] = bfhi(pw.y) + v0[3] * bfhi(gw.y);
                o1[0] = bflo(pw.z) + v1[0] * bflo(gw.z); o1[1] = bfhi(pw.z) + v1[1] * bfhi(gw.z); o1[2] = bflo(pw.w) + v1[2] * bflo(gw.w); o1[3] = bfhi(pw.w) + v1[3] * bfhi(gw.w);
                *(u32x4*)(MG + (size_t)r * DM + c0) = pack8(o0, o1);
            EPI_ROWS_END
        }
    }
};
struct EpiYss {
    bf16_t* Y; float* ss;
    __device__ __forceinline__ void operator()(const f32x4 (&acc)[2][2][4][2], const Unit& u, int wr, int wc, int fr, int fq) const {
#pragma unroll
        for (int ai = 0; ai < 2; ++ai)
#pragma unroll
            for (int m = 0; m < 4; ++m) { const int r = u.pm * BM + ai * HALF + wr * 64 + m * 16 + fr; float q = 0.f;
#pragma unroll
                for (int bj = 0; bj < 2; ++bj) { const f32x4 v0 = acc[ai][bj][m][0], v1 = acc[ai][bj][m][1]; const int c0 = u.pn * BM + bj * HALF + wc * 32 + fq * 8;
#pragma unroll
                    for (int e = 0; e < 4; ++e) q += v0[e] * v0[e] + v1[e] * v1[e];
                    *(u32x4*)(Y + (size_t)r * DM + c0) = pack8(v0, v1); }
                q += __shfl_xor(q, 16); q += __shfl_xor(q, 32);
                if (fq == 0) ss[(size_t)r * 16 + u.pn * 4 + wc] = q; }
    }
};
struct EpiRelu2 {
    bf16_t* H;
    __device__ __forceinline__ void operator()(const f32x4 (&acc)[2][2][4][2], const Unit& u, int wr, int wc, int fr, int fq) const {
        EPI_ROWS_BEGIN
            f32x4 o0, o1;
#pragma unroll
            for (int e = 0; e < 4; ++e) { const float a = fmaxf(v0[e], 0.f), b = fmaxf(v1[e], 0.f); o0[e] = a * a; o1[e] = b * b; }
            *(u32x4*)(H + (size_t)r * DFF + c0) = pack8(o0, o1);
        EPI_ROWS_END
    }
};
}

constexpr size_t MiB = 1u << 20;
constexpr size_t WS_CTL = 0, CTL_ZERO_BYTES = 64 * 1024;
constexpr size_t WS_WIN = 1 * MiB, WS_WCAT = 12 * MiB, WS_WOUT = 14 * MiB, WS_WMI = 16 * MiB, WS_WMO = 24 * MiB, WS_WSP = 32 * MiB, WS_ROPE = 33 * MiB;
constexpr size_t WS_ZST = 36 * MiB, WS_SS1 = 40 * MiB, WS_SS2 = 44 * MiB;
constexpr size_t WS_XB = 48 * MiB;
constexpr size_t WS_RS0 = 35 * MiB, WS_RS2 = 35 * MiB + 512 * 1024;
constexpr size_t WS_YC = 304 * MiB;
constexpr size_t WS_Y2 = 720 * MiB;
constexpr size_t WS_Q = 176 * MiB, WS_K = 272 * MiB, WS_V = 368 * MiB, WS_U = 464 * MiB, WS_Z = 528 * MiB, WS_GA = 592 * MiB, WS_GB = 720 * MiB, WS_OG = 848 * MiB, WS_LSE = 944 * MiB;
constexpr size_t WS_MG = 176 * MiB;
constexpr size_t WS_Y = 464 * MiB;
constexpr size_t WS_H = 176 * MiB;
constexpr size_t WS_END = 948 * MiB;
constexpr int CW_BAR = 1024;

constexpr int RING_BYTES = 131072, LDSCTL_OFF = RING_BYTES, MISC_OFF = LDSCTL_OFF + 320, LDS_BYTES = 147456;

#define XB_TMO      128
#define XB_XCNT(j)  (256  + 64 * (j))
#define XB_XSUB(j)  (1280 + 64 * (j))
#define XB_XGEN(j)  (2304 + 64 * (j))
#define XB_TOP      3328
#define XB_TOPGEN   3392
#define XCD_BAR_WORDS 3456
#define XB_SPIN_CAP (1u << 22)
__device__ __forceinline__ unsigned xb_ld(unsigned* p)              { return __hip_atomic_load(p, __ATOMIC_RELAXED, __HIP_MEMORY_SCOPE_AGENT); }
__device__ __forceinline__ unsigned xb_add(unsigned* p, unsigned v) { return __hip_atomic_fetch_add(p, v, __ATOMIC_RELAXED, __HIP_MEMORY_SCOPE_AGENT); }
__device__ __forceinline__ unsigned xb_xcc_id() { return (unsigned)__builtin_amdgcn_s_getreg((3 << 11) | 20) & 0xFu; }
#define XB_SPIN(cond, bar) do { unsigned _sp = 0; while (cond) { __builtin_amdgcn_s_sleep(1); \
    if ((++_sp & 255u) == 0u) { if (xb_ld(&(bar)[XB_TMO])) break; if (_sp > XB_SPIN_CAP) { atomicAdd(&(bar)[XB_TMO], 1u); break; } } } } while (0)
struct XcdBarrier { unsigned* bar; unsigned x; volatile LAS unsigned* st; };
__device__ __forceinline__ XcdBarrier xcd_barrier_post(unsigned* bar, volatile LAS unsigned* st) {
    XcdBarrier b; b.bar = bar; b.x = xb_xcc_id(); b.st = st;
    if (threadIdx.x == 0) (void)xb_add(&bar[XB_XCNT(b.x)], 1u);
    return b;
}
__device__ __forceinline__ void xcd_barrier_complete(unsigned* bar, unsigned x, unsigned& nloc, unsigned& nx) {
    const unsigned G = gridDim.x * gridDim.y * gridDim.z;
    unsigned sum, cnt, mine, sp = 0u;
    for (;;) {
        sum = 0u; cnt = 0u; mine = 0u;
#pragma unroll
        for (unsigned j = 0; j < 16; ++j) { const unsigned c = xb_ld(&bar[XB_XCNT(j)]); sum += c; cnt += (c > 0u) ? 1u : 0u; mine = (j == x) ? c : mine; }
        if (sum == G) break;
        __builtin_amdgcn_s_sleep(1);
        if ((++sp & 255u) == 0u) { if (xb_ld(&bar[XB_TMO])) break; if (sp > XB_SPIN_CAP) { atomicAdd(&bar[XB_TMO], 1u); break; } }
    }
    nloc = mine > 0u ? mine : 1u; nx = cnt > 0u ? cnt : 1u;
}
__device__ __forceinline__ void xcd_barrier(const XcdBarrier& b) {
    asm volatile("s_waitcnt vmcnt(0)" ::: "memory");
    __syncthreads();
    if (threadIdx.x == 0) {
        unsigned* bar = b.bar;
        __builtin_amdgcn_s_waitcnt(0);
        unsigned nloc = b.st[0], nx = b.st[1];
        if (nloc == 0u) { xcd_barrier_complete(bar, b.x, nloc, nx); b.st[0] = nloc; b.st[1] = nx; }
        const unsigned old = xb_add(&bar[XB_XSUB(b.x)], 1u);
        const unsigned gen = old / nloc;
        if (old + 1u == (gen + 1u) * nloc) {
            __builtin_amdgcn_fence(__ATOMIC_RELEASE, "agent");
            asm volatile("s_waitcnt vmcnt(0)" ::: "memory");
            const unsigned og = xb_add(&bar[XB_TOP], 1u);
            const unsigned tg = og / nx;
            if (og + 1u == (tg + 1u) * nx) xb_add(&bar[XB_TOPGEN], 1u);
            else XB_SPIN(xb_ld(&bar[XB_TOPGEN]) == tg, bar);
            __builtin_amdgcn_fence(__ATOMIC_ACQUIRE, "agent");
            xb_add(&bar[XB_XGEN(b.x)], 1u);
            asm volatile("s_waitcnt vmcnt(0)" ::: "memory");
        } else {
            XB_SPIN(xb_ld(&bar[XB_XGEN(b.x)]) == gen, bar);
            __builtin_amdgcn_fence(__ATOMIC_ACQUIRE, "agent");
            asm volatile("s_waitcnt vmcnt(0)" ::: "memory");
        }
    }
    __syncthreads();
}

constexpr int NWAVES = 8;
struct Args { const float* in[15]; float* out; unsigned char* ws; int ph_lo, ph_hi; };
struct Frame { LAS unsigned char* lds; int tid, lane, wave, vcu, G; };

__device__ __forceinline__ float wave_sum(float v) {
#pragma unroll
    for (int o = 1; o < 64; o <<= 1) v += __shfl_xor(v, o);
    return v;
}

__constant__ float c_invfreq[32] = {1.000000000e+00f, 7.498942614e-01f, 5.623413324e-01f, 4.216965139e-01f, 3.162277639e-01f, 2.371373773e-01f, 1.778279394e-01f, 1.333521307e-01f,
    1.000000015e-01f, 7.498941571e-02f, 5.623413250e-02f, 4.216965288e-02f, 3.162277490e-02f, 2.371373773e-02f, 1.778279431e-02f, 1.333521493e-02f,
    9.999999776e-03f, 7.498941850e-03f, 5.623413250e-03f, 4.216964822e-03f, 3.162277630e-03f, 2.371373586e-03f, 1.778279431e-03f, 1.333521446e-03f,
    1.000000047e-03f, 7.498942432e-04f, 5.623413017e-04f, 4.216965172e-04f, 3.162277571e-04f, 2.371373703e-04f, 1.778279402e-04f, 1.333521504e-04f};

__device__ __forceinline__ void p0_transpose_item(const float* W, int N, bf16_t* WT, int ldd, int koff, bool qkperm, const float* kgain, LAS float* scr, int kb, int nb, int lane) {
    const int k0 = 64 * kb, n0 = 32 * nb;
    int nd = n0 + (lane & 31), nsrc = nd;
    if (qkperm) { const int dp = nd & 63; nsrc = (nd & ~63) + ((dp & 1) ? 32 + (dp >> 1) : (dp >> 1)); }
#pragma unroll 8
    for (int i = 0; i < 32; ++i) { const int kk = 2 * i + (lane >> 5); const float gk = kgain ? kgain[k0 + kk] : 1.0f; scr[kk * 33 + (lane & 31)] = W[(size_t)(k0 + kk) * N + nsrc] * gk; }
    asm volatile("s_waitcnt lgkmcnt(0)" ::: "memory");
    const int c = lane & 7;
#pragma unroll
    for (int j = 0; j < 4; ++j) { const int n = (lane >> 3) + 8 * j; const LAS float* s = scr + (8 * c) * 33 + n;
        u32x4 o; o.x = cvtpk(s[0 * 33], s[1 * 33]); o.y = cvtpk(s[2 * 33], s[3 * 33]); o.z = cvtpk(s[4 * 33], s[5 * 33]); o.w = cvtpk(s[6 * 33], s[7 * 33]);
        *(u32x4*)(WT + (size_t)(n0 + n) * ldd + koff + k0 + 8 * c) = o; }
    asm volatile("s_waitcnt lgkmcnt(0)" ::: "memory");
}

__device__ __forceinline__ void p0_prologue(const Frame& F, const Args& a) {
    unsigned char* ws = a.ws;
    LAS float* scr = (LAS float*)(F.lds + F.wave * 16384);
    const int gw = F.vcu * NWAVES + F.wave, NGW = F.G * NWAVES;
    const float* w_in = a.in[2]; const float* w_ba = a.in[7]; const float* w_bg = a.in[8]; const float* w_out = a.in[9]; const float* w_mi = a.in[12]; const float* w_mo = a.in[13];
    constexpr int I_IN = (DM / 64) * (INW / 32), I_BA = (AOW / 64) * (DM / 32), I_BG = (GW / 64) * (DM / 32), I_OUT = (DM / 64) * (DM / 32), I_MI = (DM / 64) * (DFF / 32), I_MO = (DFF / 64) * (DM / 32);
    constexpr int NITEMS = I_IN + I_BA + I_BG + I_OUT + I_MI + I_MO;
    for (int it = gw; it < NITEMS; it += NGW) {
        int r = it;
        if (r < I_IN) { const int nblk = INW / 32, kb = r / nblk, nb = r % nblk; p0_transpose_item(w_in, INW, (bf16_t*)(ws + WS_WIN), DM, 0, nb < (2 * AW / 32), a.in[1], scr, kb, nb, F.lane); continue; } r -= I_IN;
        if (r < I_BA) { const int nblk = DM / 32, kb = r / nblk, nb = r % nblk; p0_transpose_item(w_ba, DM, (bf16_t*)(ws + WS_WCAT), AOW + GW, 0, false, nullptr, scr, kb, nb, F.lane); continue; } r -= I_BA;
        if (r < I_BG) { const int nblk = DM / 32, kb = r / nblk, nb = r % nblk; p0_transpose_item(w_bg, DM, (bf16_t*)(ws + WS_WCAT), AOW + GW, AOW, false, nullptr, scr, kb, nb, F.lane); continue; } r -= I_BG;
        if (r < I_OUT) { const int nblk = DM / 32, kb = r / nblk, nb = r % nblk; p0_transpose_item(w_out, DM, (bf16_t*)(ws + WS_WOUT), DM, 0, false, nullptr, scr, kb, nb, F.lane); continue; } r -= I_OUT;
        if (r < I_MI) { const int nblk = DFF / 32, kb = r / nblk, nb = r % nblk; p0_transpose_item(w_mi, DFF, (bf16_t*)(ws + WS_WMI), DM, 0, false, a.in[11], scr, kb, nb, F.lane); continue; } r -= I_MI;
        { const int nblk = DM / 32, kb = r / nblk, nb = r % nblk; p0_transpose_item(w_mo, DM, (bf16_t*)(ws + WS_WMO), DFF, 0, false, nullptr, scr, kb, nb, F.lane); }
    }
    const int gt = F.vcu * (NWAVES * 64) + F.tid, NGT = F.G * NWAVES * 64;
    { const float* wsp = a.in[3]; bf16_t* o = (bf16_t*)(ws + WS_WSP);
      for (int e = gt; e < 4 * 128 * 128 / 2; e += NGT) { const int i = (e >> 6) & 127, j = (e & 63) * 2; const f32x2 w = *(const f32x2*)(wsp + 2 * (size_t)e);
          *(unsigned*)(o + 2 * (size_t)e) = cvtpk(j <= i ? w.x : 0.f, (j + 1) <= i ? w.y : 0.f); } }
    { f32x2* T = (f32x2*)(ws + WS_ROPE);
      for (int e = gt; e < SEQ * 32; e += NGT) { const int s = e >> 5, i = e & 31; const float ang = (float)s * c_invfreq[i];
          double rev = (double)ang * 0.15915494309189535; rev -= __builtin_floor(rev); const float f = (float)rev;
          T[e] = (f32x2){__builtin_amdgcn_cosf(f), __builtin_amdgcn_sinf(f)}; } }
    { const float* x = a.in[0]; bf16_t* XB = (bf16_t*)(ws + WS_XB); float* INV0 = (float*)(ws + WS_RS0);
      f32x4 v[4], nx[4];
      if (gw < MROWS) { const f32x4* xr = (const f32x4*)(x + (size_t)gw * DM) + F.lane;
#pragma unroll
          for (int j = 0; j < 4; ++j) nx[j] = xr[64 * j]; }
      for (int m = gw; m < MROWS; m += NGW) {
#pragma unroll
          for (int j = 0; j < 4; ++j) v[j] = nx[j];
          if (m + NGW < MROWS) { const f32x4* xr = (const f32x4*)(x + (size_t)(m + NGW) * DM) + F.lane;
#pragma unroll
              for (int j = 0; j < 4; ++j) nx[j] = xr[64 * j]; }
          float s = 0.f;
#pragma unroll
          for (int j = 0; j < 4; ++j) s += (v[j].x * v[j].x + v[j].y * v[j].y) + (v[j].z * v[j].z + v[j].w * v[j].w);
          const float ms = wave_sum(s) * (1.f / DM) + EPS; const float rs = 1.0f / sqrtf(ms);
          u32x2* o8 = (u32x2*)(XB + (size_t)m * DM) + F.lane;
#pragma unroll
          for (int j = 0; j < 4; ++j) o8[64 * j] = (u32x2){cvtpk(v[j].x * rs, v[j].y * rs), cvtpk(v[j].z * rs, v[j].w * rs)};
          if (F.lane == 0) INV0[m] = sqrtf(ms);
      } }
}

constexpr int KP = 72;
constexpr int ATT_KS = 0, ATT_VS = 384 * KP * 2;
typedef short v4i16_t __attribute__((ext_vector_type(4)));
__device__ __forceinline__ f32x4 mfma16(bf16x8 a, bf16x8 b, f32x4 c) { return __builtin_amdgcn_mfma_f32_16x16x32_bf16(a, b, c, 0, 0, 0); }
__device__ __forceinline__ s16x4 ldtr(const LAS unsigned char* p) { return __builtin_bit_cast(s16x4, __builtin_amdgcn_ds_read_tr16_b64_v4i16((LAS v4i16_t*)p)); }
struct AttDU { size_t rowb; int np; };
__device__ __forceinline__ AttDU att_decode(int du) {
    AttDU u; const int bh = du >> 5, idx = du & 31, h = bh % 12; const int dl = (h >> 2) * 2; const int nper = (SEQ >> dl) >> 8;
    const int r = idx / nper; u.np = idx % nper; u.rowb = (size_t)bh * SEQ + (size_t)r * (SEQ >> dl) + 256 * u.np; return u;
}
__device__ __forceinline__ void att_load(const AttDU& u, const bf16_t* Q, const bf16_t* K, const bf16_t* V, int tid, int wave, int l15, int g4, u32x4 (&kr)[6], u32x4 (&vr)[6], bf16x8 (&qf)[2][2]) {
#pragma unroll
    for (int it = 0; it < 6; ++it) { const int p = tid + 512 * it, key = p >> 3, ch = p & 7; kr[it] = (u32x4){0u, 0u, 0u, 0u}; vr[it] = (u32x4){0u, 0u, 0u, 0u};
        if (u.np > 0 || key >= 128) { const size_t off = (u.rowb + key - 128) * 64 + ch * 8; kr[it] = *(const u32x4*)(K + off); vr[it] = *(const u32x4*)(V + off); } }
#pragma unroll
    for (int tt = 0; tt < 2; ++tt) { const size_t qrow = u.rowb + 16 * (2 * wave + tt) + l15;
#pragma unroll
        for (int ks = 0; ks < 2; ++ks) qf[tt][ks] = *(const bf16x8*)(Q + qrow * 64 + ks * 32 + g4 * 8); }
}
__device__ __forceinline__ void attn_phase(const Frame& F, const Args& a) {
    unsigned char* ws = a.ws;
    const bf16_t* Q = (const bf16_t*)(ws + WS_Q); const bf16_t* K = (const bf16_t*)(ws + WS_K); const bf16_t* V = (const bf16_t*)(ws + WS_V);
    bf16_t* OG = (bf16_t*)(ws + WS_OG); float* LSE = (float*)(ws + WS_LSE);
    LAS unsigned char* Ks = F.lds + ATT_KS; LAS unsigned char* Vs = F.lds + ATT_VS;
    const int l15 = F.lane & 15, g4 = F.lane >> 4;
    constexpr int NDU = BATCH * 12 * 32;
    for (int e = F.tid; e < 16 * KP / 2; e += 512) *(LAS unsigned*)(Vs + 384 * KP * 2 + e * 4) = 0u;
    u32x4 kr[6], vr[6]; bf16x8 qn[2][2];
    int du = F.vcu;
    AttDU u = att_decode(du < NDU ? du : 0);
    if (du < NDU) att_load(u, Q, K, V, F.tid, F.wave, l15, g4, kr, vr, qn);
    for (; du < NDU; du += F.G) {
#pragma unroll
        for (int it = 0; it < 6; ++it) { const int p = F.tid + 512 * it, key = p >> 3, ch = p & 7;
            *(LAS u32x4*)(Ks + (key * KP + ch * 8) * 2) = kr[it]; *(LAS u32x4*)(Vs + (key * KP + ch * 8) * 2) = vr[it]; }
        bf16x8 qf[2][2];
#pragma unroll
        for (int tt = 0; tt < 2; ++tt)
#pragma unroll
            for (int ks = 0; ks < 2; ++ks) qf[tt][ks] = qn[tt][ks];
        const AttDU cu = u;
        const int dn = du + F.G;
        if (dn < NDU) { u = att_decode(dn); att_load(u, Q, K, V, F.tid, F.wave, l15, g4, kr, vr, qn); }
        __syncthreads();
#pragma unroll 1
        for (int tt = 0; tt < 2; ++tt) {
            const int t = 2 * F.wave + tt;
            const size_t qrow = cu.rowb + 16 * t + l15;
            const bf16x8 q0 = tt ? qf[1][0] : qf[0][0], q1 = tt ? qf[1][1] : qf[0][1];
            f32x4 s[9];
            {   const LAS unsigned char* kb = Ks + ((16 * t + l15) * KP + g4 * 8) * 2;
                bf16x8 kf[9];
#pragma unroll
                for (int kt = 0; kt < 9; ++kt) kf[kt] = *(const LAS bf16x8*)(kb + kt * 16 * KP * 2);
#pragma unroll
                for (int kt = 0; kt < 9; ++kt) s[kt] = mfma16(kf[kt], q0, (f32x4){0.f, 0.f, 0.f, 0.f});
#pragma unroll
                for (int kt = 0; kt < 9; ++kt) kf[kt] = *(const LAS bf16x8*)(kb + kt * 16 * KP * 2 + 64);
#pragma unroll
                for (int kt = 0; kt < 9; ++kt) s[kt] = mfma16(kf[kt], q1, s[kt]); }
            const int qi = 16 * t + l15; float mx = -3.0e38f;
#pragma unroll
            for (int kt = 0; kt < 9; ++kt)
#pragma unroll
                for (int e = 0; e < 4; ++e) { const int j = 16 * (t + kt) + 4 * g4 + e; const bool ok = (j >= qi) && (j <= qi + 128) && (cu.np > 0 || j >= 128);
                    s[kt][e] = ok ? s[kt][e] : -1.0e30f; mx = fmaxf(mx, s[kt][e]); }
            mx = fmaxf(mx, __shfl_xor(mx, 16)); mx = fmaxf(mx, __shfl_xor(mx, 32));
            float sum = 0.f;
#pragma unroll
            for (int kt = 0; kt < 9; ++kt)
#pragma unroll
                for (int e = 0; e < 4; ++e) { s[kt][e] = __builtin_amdgcn_exp2f(s[kt][e] - mx); sum += s[kt][e]; }
            sum += __shfl_xor(sum, 16); sum += __shfl_xor(sum, 32);
            bf16x8 pf[5];
#pragma unroll
            for (int s5 = 0; s5 < 5; ++s5) { u32x4 w; w.x = cvtpk(s[2 * s5][0], s[2 * s5][1]); w.y = cvtpk(s[2 * s5][2], s[2 * s5][3]);
                if (s5 < 4) { w.z = cvtpk(s[2 * s5 + 1][0], s[2 * s5 + 1][1]); w.w = cvtpk(s[2 * s5 + 1][2], s[2 * s5 + 1][3]); } else { w.z = 0u; w.w = 0u; }
                pf[s5] = __builtin_bit_cast(bf16x8, w); }
            const float inv = 1.0f / sum;
            f32x4 o[4];
#pragma unroll
            for (int dt = 0; dt < 4; ++dt) o[dt] = (f32x4){0.f, 0.f, 0.f, 0.f};
            {
                const LAS unsigned char* vb = Vs + ((16 * t + 4 * g4 + (l15 >> 2)) * KP + 4 * (l15 & 3)) * 2;
#pragma unroll
                for (int s5 = 0; s5 < 5; ++s5) { s16x4 lo[4], hi[4];
#pragma unroll
                    for (int dt = 0; dt < 4; ++dt) { lo[dt] = ldtr(vb + (32 * s5 * KP + 16 * dt) * 2); hi[dt] = ldtr(vb + ((32 * s5 + 16) * KP + 16 * dt) * 2); }
#pragma unroll
                    for (int dt = 0; dt < 4; ++dt) o[dt] = mfma16(__builtin_shufflevector(lo[dt], hi[dt], 0, 1, 2, 3, 4, 5, 6, 7), pf[s5], o[dt]); } }
#pragma unroll
            for (int dt = 0; dt < 4; ++dt) *(u32x2*)(OG + qrow * 64 + 16 * dt + 4 * g4) = (u32x2){cvtpk(o[dt][0] * inv, o[dt][1] * inv), cvtpk(o[dt][2] * inv, o[dt][3] * inv)};
            if (g4 == 0) LSE[qrow] = mx + __builtin_amdgcn_logf(sum);
        }
        __syncthreads();
    }
}

constexpr int ZP = 136;
__device__ __forceinline__ void gmlp_phase(const Frame& F, const Args& a) {
    unsigned char* ws = a.ws;
    const bf16_t* U = (const bf16_t*)(ws + WS_U); const bf16_t* Z = (const bf16_t*)(ws + WS_Z); const f32x2* zst = (const f32x2*)(ws + WS_ZST);
    const bf16_t* Wsp = (const bf16_t*)(ws + WS_WSP); bf16_t* YC = (bf16_t*)(ws + WS_YC);
    const float* bsp = a.in[4]; const float* lng = a.in[5]; const float* lnb = a.in[6];
    LAS unsigned char* Zs = F.lds; LAS f32x2* st = (LAS f32x2*)(F.lds + 128 * ZP * 2);
    const int l15 = F.lane & 15, g4 = F.lane >> 4, w = F.wave;
    constexpr int NUN = (MROWS / 128) * 4;
    u32x4 zr[4]; f32x2 sr = {0.f, 0.f};
    int un = F.vcu;
#define GM_LOAD(unit) do { const int c_ = (unit) >> 2, grp_ = (unit) & 3; const size_t tok0_ = (size_t)c_ * 128; \
        _Pragma("unroll") for (int it = 0; it < 4; ++it) { const int p = F.tid + 512 * it, j = p >> 4, c8 = p & 15; zr[it] = *(const u32x4*)(Z + (tok0_ + j) * GW + grp_ * 128 + c8 * 8); } \
        if (F.tid < 128) { const f32x4* p4 = (const f32x4*)(zst + (tok0_ + F.tid) * 8); float s_ = 0.f, q_ = 0.f; \
            _Pragma("unroll") for (int e = 0; e < 4; ++e) { const f32x4 v = p4[e]; s_ += v.x + v.z; q_ += v.y + v.w; } \
            const float mean = s_ * (1.f / GW), var = fmaxf(q_ * (1.f / GW) - mean * mean, 0.f); sr = (f32x2){mean, 1.0f / sqrtf(var + EPS)}; } } while (0)
    if (un < NUN) GM_LOAD(un);
    for (; un < NUN; un += F.G) {
        const int c = un >> 2, grp = un & 3; const size_t tok0 = (size_t)c * 128;
        if (F.tid < 128) st[F.tid] = sr;
        __syncthreads();
#pragma unroll
        for (int it = 0; it < 4; ++it) { const int p = F.tid + 512 * it, j = p >> 4, c8 = p & 15; const u32x4 zv = zr[it];
            const f32x4 ga = *(const f32x4*)(lng + grp * 128 + c8 * 8), gb = *(const f32x4*)(lng + grp * 128 + c8 * 8 + 4);
            const f32x4 ba = *(const f32x4*)(lnb + grp * 128 + c8 * 8), bb = *(const f32x4*)(lnb + grp * 128 + c8 * 8 + 4);
            const f32x2 ms = st[j];
            u32x4 o;
            o.x = cvtpk((bflo(zv.x) - ms.x) * ms.y * ga[0] + ba[0], (bfhi(zv.x) - ms.x) * ms.y * ga[1] + ba[1]);
            o.y = cvtpk((bflo(zv.y) - ms.x) * ms.y * ga[2] + ba[2], (bfhi(zv.y) - ms.x) * ms.y * ga[3] + ba[3]);
            o.z = cvtpk((bflo(zv.z) - ms.x) * ms.y * gb[0] + bb[0], (bfhi(zv.z) - ms.x) * ms.y * gb[1] + bb[1]);
            o.w = cvtpk((bflo(zv.w) - ms.x) * ms.y * gb[2] + bb[2], (bfhi(zv.w) - ms.x) * ms.y * gb[3] + bb[3]);
            *(LAS u32x4*)(Zs + (j * ZP + c8 * 8) * 2) = o; }
        const int nu = un + F.G;
        if (nu < NUN) GM_LOAD(nu);
        __syncthreads();
        {
            bf16x8 wf[4];
#pragma unroll
            for (int ks = 0; ks < 4; ++ks) if (ks <= (w >> 1)) wf[ks] = *(const bf16x8*)(Wsp + ((size_t)(grp * 128 + 16 * w + l15)) * 128 + ks * 32 + g4 * 8);
            const int i = 16 * w + l15; const size_t tok = tok0 + i; const float bi = bsp[grp * 128 + i];
            f32x4 acc[8]; u32x2 uv[8];
#pragma unroll
            for (int mt = 0; mt < 8; ++mt) { acc[mt] = (f32x4){0.f, 0.f, 0.f, 0.f}; uv[mt] = *(const u32x2*)(U + tok * GW + grp * 128 + 16 * mt + 4 * g4); }
#pragma unroll
            for (int ks = 0; ks < 4; ++ks) if (ks <= (w >> 1)) {
                const LAS unsigned char* zb = Zs + ((32 * ks + 8 * g4 + (l15 >> 2)) * ZP + 4 * (l15 & 3)) * 2;
                s16x4 lo[8], hi[8];
#pragma unroll
                for (int mt = 0; mt < 8; ++mt) { lo[mt] = ldtr(zb + 16 * mt * 2); hi[mt] = ldtr(zb + (4 * ZP + 16 * mt) * 2); }
#pragma unroll
                for (int mt = 0; mt < 8; ++mt) acc[mt] = mfma16(__builtin_shufflevector(lo[mt], hi[mt], 0, 1, 2, 3, 4, 5, 6, 7), wf[ks], acc[mt]); }
#pragma unroll
            for (int mt = 0; mt < 8; ++mt) { const int ch = 16 * mt + 4 * g4;
                const float o0 = bflo(uv[mt].x) * (acc[mt][0] + bi), o1 = bfhi(uv[mt].x) * (acc[mt][1] + bi), o2 = bflo(uv[mt].y) * (acc[mt][2] + bi), o3 = bfhi(uv[mt].y) * (acc[mt][3] + bi);
                *(u32x2*)(YC + tok * (AOW + GW) + AOW + grp * 128 + ch) = (u32x2){cvtpk(o0, o1), cvtpk(o2, o3)}; }
        }
        __syncthreads();
    }
#undef GM_LOAD
}
__device__ __forceinline__ void combine_phase(const Frame& F, const Args& a) {
    unsigned char* ws = a.ws;
    const bf16_t* OG = (const bf16_t*)(ws + WS_OG); const float* LSE = (const float*)(ws + WS_LSE); bf16_t* YC = (bf16_t*)(ws + WS_YC);
    const int gt = F.vcu * (NWAVES * 64) + F.tid, NGT = F.G * NWAVES * 64;
    for (int it = gt; it < MROWS * 32; it += NGT) {
        const size_t tok = (size_t)(it >> 5); const int j = (it >> 3) & 3, c8 = it & 7;
        const int bb = (int)(tok >> 13), tt = (int)(tok & (SEQ - 1)); const size_t r0 = hrow(bb, tt, j), r1 = hrow(bb, tt, 4 + j), r2 = hrow(bb, tt, 8 + j);
        const float l0 = LSE[r0], l1 = LSE[r1], l2 = LSE[r2];
        const float m = fmaxf(l0, fmaxf(l1, l2));
        float w0 = __builtin_amdgcn_exp2f(l0 - m), w1 = __builtin_amdgcn_exp2f(l1 - m), w2 = __builtin_amdgcn_exp2f(l2 - m);
        const float inv = 1.0f / (w0 + w1 + w2); w0 *= inv; w1 *= inv; w2 *= inv;
        const u32x4 a0 = *(const u32x4*)(OG + r0 * 64 + c8 * 8), a1 = *(const u32x4*)(OG + r1 * 64 + c8 * 8), a2 = *(const u32x4*)(OG + r2 * 64 + c8 * 8);
        u32x4 o;
        o.x = cvtpk(w0 * bflo(a0.x) + w1 * bflo(a1.x) + w2 * bflo(a2.x), w0 * bfhi(a0.x) + w1 * bfhi(a1.x) + w2 * bfhi(a2.x));
        o.y = cvtpk(w0 * bflo(a0.y) + w1 * bflo(a1.y) + w2 * bflo(a2.y), w0 * bfhi(a0.y) + w1 * bfhi(a1.y) + w2 * bfhi(a2.y));
        o.z = cvtpk(w0 * bflo(a0.z) + w1 * bflo(a1.z) + w2 * bflo(a2.z), w0 * bfhi(a0.z) + w1 * bfhi(a1.z) + w2 * bfhi(a2.z));
        o.w = cvtpk(w0 * bflo(a0.w) + w1 * bflo(a1.w) + w2 * bflo(a2.w), w0 * bfhi(a0.w) + w1 * bfhi(a1.w) + w2 * bfhi(a2.w));
        *(u32x4*)(YC + tok * (AOW + GW) + j * 64 + c8 * 8) = o;
    }
}
__device__ __forceinline__ void rowpass1(const Frame& F, const Args& a) {
    unsigned char* ws = a.ws;
    const float* g1 = a.in[10];
    const bf16_t* Y = (const bf16_t*)(ws + WS_Y); const float* ss = (const float*)(ws + WS_SS1); bf16_t* XB = (bf16_t*)(ws + WS_XB); const float* INV0 = (const float*)(ws + WS_RS0); float* INV2 = (float*)(ws + WS_RS2);
    const int gw = F.vcu * NWAVES + F.wave, NGW = F.G * NWAVES;
    f32x4 g1v[4];
#pragma unroll
    for (int j = 0; j < 4; ++j) g1v[j] = *((const f32x4*)g1 + F.lane + 64 * j);
    u32x2 nxv[4], nyv[4]; float npart = 0.f, ninv = 0.f;
#define RP1_LOAD(mm) do { const u32x2* xr_ = (const u32x2*)(XB + (size_t)(mm) * DM) + F.lane; const u32x2* yr_ = (const u32x2*)(Y + (size_t)(mm) * DM) + F.lane; \
        _Pragma("unroll") for (int j = 0; j < 4; ++j) { nxv[j] = xr_[64 * j]; nyv[j] = yr_[64 * j]; } npart = (F.lane < 16) ? ss[(size_t)(mm) * 16 + F.lane] : 0.f; ninv = INV0[mm]; } while (0)
    if (gw < MROWS) RP1_LOAD(gw);
    for (int m = gw; m < MROWS; m += NGW) {
        u32x2 xv[4], yv[4];
#pragma unroll
        for (int j = 0; j < 4; ++j) { xv[j] = nxv[j]; yv[j] = nyv[j]; }
        const float part = npart, inv0 = ninv;
        if (m + NGW < MROWS) RP1_LOAD(m + NGW);
        const float rs1 = 1.0f / sqrtf(wave_sum(part) * (1.f / DM) + EPS);
        f32x4 v[4]; float s = 0.f;
#pragma unroll
        for (int j = 0; j < 4; ++j) { const f32x4 xf = {bflo(xv[j].x), bfhi(xv[j].x), bflo(xv[j].y), bfhi(xv[j].y)}, yf = {bflo(yv[j].x), bfhi(yv[j].x), bflo(yv[j].y), bfhi(yv[j].y)};
            v[j] = xf * inv0 + yf * rs1 * g1v[j]; s += (v[j].x * v[j].x + v[j].y * v[j].y) + (v[j].z * v[j].z + v[j].w * v[j].w); }
        const float ms = wave_sum(s) * (1.f / DM) + EPS; const float rs2 = 1.0f / sqrtf(ms);
        u32x2* xw = (u32x2*)(XB + (size_t)m * DM) + F.lane;
#pragma unroll
        for (int j = 0; j < 4; ++j) xw[64 * j] = (u32x2){cvtpk(v[j].x * rs2, v[j].y * rs2), cvtpk(v[j].z * rs2, v[j].w * rs2)};
        if (F.lane == 0) INV2[m] = sqrtf(ms);
    }
#undef RP1_LOAD
}
__device__ __forceinline__ void rowpass2(const Frame& F, const Args& a) {
    unsigned char* ws = a.ws;
    const float* g4v_ = a.in[14]; const bf16_t* Y2 = (const bf16_t*)(ws + WS_Y2); const bf16_t* XB = (const bf16_t*)(ws + WS_XB); const float* ss = (const float*)(ws + WS_SS2); const float* INV2 = (const float*)(ws + WS_RS2); float* out = a.out;
    const int gw = F.vcu * NWAVES + F.wave, NGW = F.G * NWAVES;
    f32x4 gv[4];
#pragma unroll
    for (int j = 0; j < 4; ++j) gv[j] = *((const f32x4*)g4v_ + F.lane + 64 * j);
    u32x2 nxv[4], nyv[4]; float npart = 0.f, ninv = 0.f;
#define RP2_LOAD(mm) do { const u32x2* xr_ = (const u32x2*)(XB + (size_t)(mm) * DM) + F.lane; const u32x2* yr_ = (const u32x2*)(Y2 + (size_t)(mm) * DM) + F.lane; \
        _Pragma("unroll") for (int j = 0; j < 4; ++j) { nxv[j] = xr_[64 * j]; nyv[j] = yr_[64 * j]; } npart = (F.lane < 16) ? ss[(size_t)(mm) * 16 + F.lane] : 0.f; ninv = INV2[mm]; } while (0)
    if (gw < MROWS) RP2_LOAD(gw);
    for (int m = gw; m < MROWS; m += NGW) {
        u32x2 xv[4], yv[4];
#pragma unroll
        for (int j = 0; j < 4; ++j) { xv[j] = nxv[j]; yv[j] = nyv[j]; }
        const float part = npart, inv2 = ninv;
        if (m + NGW < MROWS) RP2_LOAD(m + NGW);
        const float rs = 1.0f / sqrtf(wave_sum(part) * (1.f / DM) + EPS);
        f32x4* orow = (f32x4*)(out + (size_t)m * DM) + F.lane;
#pragma unroll
        for (int j = 0; j < 4; ++j) { const f32x4 xf = {bflo(xv[j].x), bfhi(xv[j].x), bflo(xv[j].y), bfhi(xv[j].y)}, yf = {bflo(yv[j].x), bfhi(yv[j].x), bflo(yv[j].y), bfhi(yv[j].y)};
            orow[64 * j] = xf * inv2 + yf * rs * gv[j]; }
    }
#undef RP2_LOAD
}

constexpr int N_PHASES = 10;
__global__ void __launch_bounds__(NWAVES * 64, 2) fwd_megakernel(Args args) {
    extern __shared__ __attribute__((aligned(16))) unsigned char lds_raw[];
    Frame F;
    F.lds = (LAS unsigned char*)lds_raw;
    F.tid = threadIdx.x; F.lane = F.tid & 63; F.wave = __builtin_amdgcn_readfirstlane(F.tid >> 6);
    F.G = gridDim.x; { const int bx = blockIdx.x; F.vcu = (F.G % 8 == 0) ? (bx % 8) * (F.G / 8) + bx / 8 : bx; }
    unsigned char* ws = args.ws;
    for (int u = F.tid; u < (LDS_BYTES - LDSCTL_OFF) / 4; u += NWAVES * 64) ((LAS unsigned*)(F.lds + LDSCTL_OFF))[u] = 0u;
    __syncthreads();
    const int lo = args.ph_lo, hi = args.ph_hi;
    const bool multi = (hi - lo) > 1;
    XcdBarrier bar; bar.bar = (unsigned*)(ws + WS_CTL) + CW_BAR; bar.x = 0; bar.st = nullptr;
    if (multi) bar = xcd_barrier_post((unsigned*)(ws + WS_CTL) + CW_BAR, (volatile LAS unsigned*)(F.lds + MISC_OFF) + 8);
#define IN(k) (lo <= (k) && (k) < hi)
#ifndef PROBE_REP
#define PROBE_REP -1
#endif
#define REPS(k) for (int rep_ = 0; rep_ < ((PROBE_REP == (k)) ? 2 : 1); ++rep_)
#define SEAM(k) do { if (IN(k) && (IN((k) + 1) || PROBE_REP == (k))) xcd_barrier(bar); } while (0)
    if (IN(0)) REPS(0) { p0_prologue(F, args); SEAM(0); }
    if (IN(1)) REPS(1) {
        pg8::Gemm g{(bf16_t*)(ws + WS_XB), nullptr, (bf16_t*)(ws + WS_WIN), nullptr, DM / 64, 0, DM, DM};
        pg8::StaticOrder S; S.init(MROWS, INW, F.G, (int)blockIdx.x, 1);
        pg8::EpiP1 E{(bf16_t*)(ws + WS_Q), (bf16_t*)(ws + WS_K), (bf16_t*)(ws + WS_V), (bf16_t*)(ws + WS_U), (bf16_t*)(ws + WS_Z), (bf16_t*)(ws + WS_GA), (bf16_t*)(ws + WS_GB), (f32x2*)(ws + WS_ZST), (const float*)(ws + WS_ROPE)};
        pg8::gemm_phase<pg8::EpiP1, true>(F.lds, g, S, E);
        SEAM(1);
    }
    if (IN(2)) REPS(2) { attn_phase(F, args); SEAM(2); }
    if (IN(3)) REPS(3) { gmlp_phase(F, args); combine_phase(F, args); SEAM(3); }
    if (IN(4)) REPS(4) {
        const bf16_t* YC = (const bf16_t*)(ws + WS_YC); const bf16_t* WC = (const bf16_t*)(ws + WS_WCAT);
        pg8::Gemm g{YC, YC + AOW, WC, WC + AOW, AOW / 64, GW / 64, AOW + GW, AOW + GW};
        pg8::StaticOrder S; S.init(MROWS, DM, F.G, (int)blockIdx.x, 2);
        pg8::EpiMerge E{(const bf16_t*)(ws + WS_GA), (const bf16_t*)(ws + WS_GB), (bf16_t*)(ws + WS_MG)};
        pg8::gemm_phase<pg8::EpiMerge, true>(F.lds, g, S, E);
        SEAM(4);
    }
    if (IN(5)) REPS(5) {
        pg8::Gemm g{(bf16_t*)(ws + WS_MG), nullptr, (bf16_t*)(ws + WS_WOUT), nullptr, DM / 64, 0, DM, DM};
        pg8::StaticOrder S; S.init(MROWS, DM, F.G, (int)blockIdx.x, 1);
        pg8::EpiYss E{(bf16_t*)(ws + WS_Y), (float*)(ws + WS_SS1)};
        pg8::gemm_phase<pg8::EpiYss, true>(F.lds, g, S, E);
        SEAM(5);
    }
    if (IN(6)) REPS(6) { rowpass1(F, args); SEAM(6); }
    if (IN(7)) REPS(7) {
        pg8::Gemm g{(bf16_t*)(ws + WS_XB), nullptr, (bf16_t*)(ws + WS_WMI), nullptr, DM / 64, 0, DM, DM};
        pg8::StaticOrder S; S.init(MROWS, DFF, F.G, (int)blockIdx.x, 1);
        pg8::EpiRelu2 E{(bf16_t*)(ws + WS_H)};
        pg8::gemm_phase<pg8::EpiRelu2, true>(F.lds, g, S, E);
        SEAM(7);
    }
    if (IN(8)) REPS(8) {
        pg8::Gemm g{(bf16_t*)(ws + WS_H), nullptr, (bf16_t*)(ws + WS_WMO), nullptr, DFF / 64, 0, DFF, DFF};
        pg8::StaticOrder S; S.init(MROWS, DM, F.G, (int)blockIdx.x, 1);
        pg8::EpiYss E{(bf16_t*)(ws + WS_Y2), (float*)(ws + WS_SS2)};
        pg8::gemm_phase<pg8::EpiYss, true>(F.lds, g, S, E);
        SEAM(8);
    }
    if (IN(9)) REPS(9) { rowpass2(F, args); }
#undef IN
#undef SEAM
}

#ifndef MK_PER_PHASE
#define MK_PER_PHASE 0
#endif
extern "C" void kernel_launch(void* const* d_in, const int* in_sizes, int n_in, void* d_out, int out_size, void* d_ws, size_t ws_size, hipStream_t stream) {
    static int grid = 0;
    if (grid == 0) {
        if (n_in != 15 || in_sizes[0] != MROWS * DM || out_size != MROWS * DM || ws_size < WS_END) { fprintf(stderr, "kernel_launch: unexpected shapes (n_in %d, in0 %d, out %d, ws %zu)\n", n_in, n_in > 0 ? in_sizes[0] : -1, out_size, ws_size); grid = -1; return; }
        int dev = 0, cus = 0, per_cu = 0;
        if (hipGetDevice(&dev) != hipSuccess || hipDeviceGetAttribute(&cus, hipDeviceAttributeMultiprocessorCount, dev) != hipSuccess) { grid = -1; return; }
        if (hipFuncSetAttribute((const void*)fwd_megakernel, hipFuncAttributeMaxDynamicSharedMemorySize, LDS_BYTES) != hipSuccess) { fprintf(stderr, "kernel_launch: hipFuncSetAttribute failed\n"); grid = -1; return; }
        if (hipOccupancyMaxActiveBlocksPerMultiprocessor(&per_cu, (const void*)fwd_megakernel, NWAVES * 64, LDS_BYTES) != hipSuccess || per_cu < 1) { fprintf(stderr, "kernel_launch: occupancy query says %d blocks per CU\n", per_cu); }
        (void)hipGetLastError();
        grid = cus;
    }
    if (grid < 0) return;
    (void)hipMemsetAsync((char*)d_ws + WS_CTL, 0, CTL_ZERO_BYTES, stream);
    Args a{};
    for (int i = 0; i < 15; ++i) a.in[i] = (const float*)d_in[i];
    a.out = (float*)d_out; a.ws = (unsigned char*)d_ws;
#if MK_PER_PHASE
    for (int p = 0; p < N_PHASES; ++p) { a.ph_lo = p; a.ph_hi = p + 1; hipLaunchKernelGGL(fwd_megakernel, dim3(grid), dim3(NWAVES * 64), LDS_BYTES, stream, a); }
#else
    a.ph_lo = 0; a.ph_hi = N_PHASES; hipLaunchKernelGGL(fwd_megakernel, dim3(grid), dim3(NWAVES * 64), LDS_BYTES, stream, a);
#endif
}
```

```cpp
#include <hip/hip_runtime.h>
#include <cstdio>
#include <cstdint>

#define LAS __attribute__((address_space(3)))
typedef unsigned short bf16_t;
typedef short bf16x8 __attribute__((ext_vector_type(8)));
typedef short s16x4 __attribute__((ext_vector_type(4)));
typedef float f32x4 __attribute__((ext_vector_type(4)));
typedef float f32x2 __attribute__((ext_vector_type(2)));
typedef unsigned u32x4 __attribute__((ext_vector_type(4)));
typedef unsigned u32x2 __attribute__((ext_vector_type(2)));
typedef __bf16 bf16x2_t __attribute__((ext_vector_type(2)));

constexpr int BATCH = 8, SEQ = 8192, DM = 1024, MROWS = BATCH * SEQ;
constexpr int AW = 768, AOW = 256, GW = 512, DFF = 4096, INW = 5376;
constexpr float EPS = 1e-6f;
constexpr float QSCALE = 0.125f * 1.4426950408889634f;

__device__ __forceinline__ unsigned cvtpk(float lo, float hi) { f32x2 v = {lo, hi}; bf16x2_t b = __builtin_convertvector(v, bf16x2_t); return __builtin_bit_cast(unsigned, b); }
__device__ __forceinline__ size_t hrow(int b, int t, int h) { const int dl = (h >> 2) * 2; return ((size_t)(b * 12 + h) * SEQ + (size_t)((t & ((1 << dl) - 1)) * (SEQ >> dl) + (t >> dl))); }
__device__ __forceinline__ float bflo(unsigned u) { return __uint_as_float(u << 16); }
__device__ __forceinline__ float bfhi(unsigned u) { return __uint_as_float(u & 0xffff0000u); }
__device__ __forceinline__ float gelu_tanh(float x) {
    const float t = x * (1.5957691216057308f + 0.07135481627159498f * x * x);
    return x * __builtin_amdgcn_rcpf(1.0f + __builtin_amdgcn_exp2f(-1.4426950408889634f * t));
}
__device__ __forceinline__ float sigmoidf_(float x) { return __builtin_amdgcn_rcpf(1.0f + __builtin_amdgcn_exp2f(-1.4426950408889634f * x)); }

namespace pg8 {
constexpr int BM = 256, BK = 64, HALF = 128, HTB = HALF * BK * 2, STAGE_BYTES = 8 * HTB, NXCD = 8, WGM = 8;
__host__ __device__ __forceinline__ int lds_byte(int r, int c) { const int st = (r >> 4) * 2 + (c >> 5), rr = r & 15, cc = c & 31, ob = rr * 64 + cc * 2; return st * 1024 + (ob ^ (((ob >> 9) & 1) << 5)); }
__host__ __device__ __forceinline__ void stage_rc(int b, int& R, int& C) { const int st = b / 1024, sb = b % 1024, swz = sb ^ (((sb >> 9) & 1) << 5); R = (st >> 1) * 16 + swz / 64; C = (st & 1) * 32 + (swz % 64) / 2; }
__host__ __device__ __forceinline__ int perm32(int rho) { const int n = rho >> 4, i = rho & 15; return 8 * (i >> 2) + 4 * n + (i & 3); }

struct Unit { int pm, pn, kind; };
struct Gemm { const bf16_t* A0; const bf16_t* A1; const bf16_t* B0; const bf16_t* B1; int nt0, nt1, lda, ldb; };

struct StaticOrder {
    int nM, nN, nwg, G, c, reps;
    __device__ void init(int M, int N, int G_, int c_, int reps_) { nM = M / BM; nN = N / BM; nwg = nM * nN; G = G_; c = c_; reps = reps_; }
    __device__ bool next(int i, Unit& u) const {
        const int it = (reps == 2) ? (i >> 1) : i; u.kind = (reps == 2) ? (i & 1) : 0;
        const long L = (long)it * G + c; if (L >= nwg) return false;
        int wgid = (int)L; { const int q = nwg / NXCD, r = nwg % NXCD, xcd = wgid % NXCD, off = wgid / NXCD; wgid = (xcd < r ? xcd * (q + 1) : r * (q + 1) + (xcd - r) * q) + off; }
        const int nig = WGM * nN, gid = wgid / nig, fm = gid * WGM, gsz = (nM - fm) < WGM ? (nM - fm) : WGM;
        u.pm = fm + ((wgid % nig) % gsz); u.pn = (wgid % nig) / gsz; return true;
    }
};

#ifndef RELAX_BOUNDARY
#define RELAX_BOUNDARY 0
#endif
template <class Epi, bool ALIGN_EPI>
__device__ __forceinline__ void gemm_phase(LAS unsigned char* lds, const Gemm g, const StaticOrder& S, const Epi& E) {
    const int tid = threadIdx.x, wid = __builtin_amdgcn_readfirstlane(tid >> 6), lane = tid & 63, wr = wid >> 2, wc = wid & 3, fr = lane & 15, fq = lane >> 4;
    unsigned voffA[2], voffB[2];
#pragma unroll
    for (int i = 0; i < 2; ++i) { int R, C; stage_rc(tid * 16 + i * 8192, R, C); const int Rb = (R & ~31) + perm32(R & 31);
        voffA[i] = (unsigned)(R * g.lda + C) * 2u; voffB[i] = (unsigned)(Rb * g.ldb + C) * 2u; }
    const size_t kstep = (size_t)(BK * 2);
    const size_t hstepA = (size_t)HALF * g.lda * 2, hstepB = (size_t)HALF * g.ldb * 2;
    const size_t tstepA = 2 * hstepA, tstepB = 2 * hstepB;
    const unsigned ldsw = (unsigned)wid * 1024u;
    const int aoff = lds_byte(wr * 64 + fr, fq * 8), boff = lds_byte(wc * 32 + fr, fq * 8);
#define PG8_SA(b, h) (((b) * 2 + (h)) * HTB)
#define PG8_SB(b, h) ((4 + (b) * 2 + (h)) * HTB)
#define PG8_STAGE(bufoff, gbase, voff) do { _Pragma("unroll") for (int _i = 0; _i < 2; ++_i) \
        __builtin_amdgcn_global_load_lds((const unsigned*)((const char*)(gbase) + (voff)[_i]), (LAS unsigned*)(lds + (bufoff) + ldsw + _i * 8192), 16, 0, 0); } while (0)
#define PG8_LDA(dst, b, h) do { _Pragma("unroll") for (int m = 0; m < 4; ++m) _Pragma("unroll") for (int k = 0; k < 2; ++k) dst[m][k] = *(const LAS bf16x8*)(lds + PG8_SA(b, h) + aoff + m * 2048 + k * 1024); } while (0)
#define PG8_LDB(dst, b, h) do { _Pragma("unroll") for (int n = 0; n < 2; ++n) _Pragma("unroll") for (int k = 0; k < 2; ++k) dst[n][k] = *(const LAS bf16x8*)(lds + PG8_SB(b, h) + boff + n * 2048 + k * 1024); } while (0)
#define PG8_MMA(ai, bj, At, Bt) do { __builtin_amdgcn_s_setprio(1); _Pragma("unroll") for (int m = 0; m < 4; ++m) _Pragma("unroll") for (int n = 0; n < 2; ++n) _Pragma("unroll") for (int k = 0; k < 2; ++k) \
        acc[ai][bj][m][n] = __builtin_amdgcn_mfma_f32_16x16x32_bf16(Bt[n][k], At[m][k], acc[ai][bj][m][n], 0, 0, 0); __builtin_amdgcn_s_setprio(0); } while (0)
#define PG8_WAIT_V(n) asm volatile("s_waitcnt vmcnt(" #n ")" ::: "memory")
#define PG8_WAIT_L(n) asm volatile("s_waitcnt lgkmcnt(" #n ")" ::: "memory")
#define PG8_BAR __builtin_amdgcn_s_barrier()
#define PG8_SCHED __builtin_amdgcn_sched_barrier(0)
    Unit cur, nxt; int ui = 0;
    if (!S.next(0, cur)) return;
#ifdef STAGGER_TICKS
    { const unsigned long long t0_ = __builtin_amdgcn_s_memrealtime(); const unsigned long long dl_ = (unsigned long long)(((unsigned)blockIdx.x >> 3) & 3u) * STAGGER_TICKS;
      while (__builtin_amdgcn_s_memrealtime() - t0_ < dl_) __builtin_amdgcn_s_sleep(8); }
#endif
    f32x4 acc[2][2][4][2];
#pragma unroll
    for (int a = 0; a < 2; ++a)
#pragma unroll
        for (int b = 0; b < 2; ++b)
#pragma unroll
            for (int m = 0; m < 4; ++m)
#pragma unroll
                for (int n = 0; n < 2; ++n) acc[a][b][m][n] = (f32x4){0.f, 0.f, 0.f, 0.f};
    bf16x8 At[4][2], B0[2][2], B1[2][2];
    const char* cA = (const char*)(cur.kind ? g.A1 : g.A0) + (size_t)cur.pm * tstepA; const char* cB = (const char*)(cur.kind ? g.B1 : g.B0) + (size_t)cur.pn * tstepB;
    int nt = cur.kind ? g.nt1 : g.nt0;
    PG8_STAGE(PG8_SB(0, 0), cB, voffB); PG8_STAGE(PG8_SB(0, 1), cB + hstepB, voffB); PG8_STAGE(PG8_SA(0, 0), cA, voffA); PG8_STAGE(PG8_SA(0, 1), cA + hstepA, voffA);
    if (wr == 1) PG8_BAR;
    PG8_WAIT_V(2); PG8_BAR;
    PG8_STAGE(PG8_SB(1, 0), cB + kstep, voffB); PG8_STAGE(PG8_SA(1, 0), cA + kstep, voffA); PG8_STAGE(PG8_SB(1, 1), cB + hstepB + kstep, voffB);
    PG8_WAIT_V(6); PG8_BAR;
    for (;;) {
        const bool has_next = S.next(ui + 1, nxt);
        const char* nA = has_next ? (const char*)(nxt.kind ? g.A1 : g.A0) + (size_t)nxt.pm * tstepA : cA; const char* nB = has_next ? (const char*)(nxt.kind ? g.B1 : g.B0) + (size_t)nxt.pn * tstepB : cB;
#define PG8_TRIP(T, WFRESH, STAGE11) do { \
            const bool last = ((T) == nt - 2); \
            const char* a1 = cA + (size_t)((T) + 1) * kstep; \
            const char* a2 = last ? nA : cA + (size_t)((T) + 2) * kstep; const char* b2 = last ? nB : cB + (size_t)((T) + 2) * kstep; \
            const char* a3 = a2 + kstep; const char* b3 = b2 + kstep; \
            PG8_LDB(B0, 0, 0); PG8_LDB(B1, 0, 1); PG8_SCHED; PG8_LDA(At, 0, 0); if (STAGE11) PG8_STAGE(PG8_SA(1, 1), a1 + hstepA, voffA); \
            PG8_WAIT_V(WFRESH); PG8_WAIT_L(0); PG8_BAR; PG8_MMA(0, 0, At, B0); PG8_MMA(0, 1, At, B1); PG8_BAR; PG8_SCHED; \
            PG8_LDA(At, 0, 1); PG8_STAGE(PG8_SB(0, 0), b2, voffB); PG8_STAGE(PG8_SB(0, 1), b2 + hstepB, voffB); PG8_STAGE(PG8_SA(0, 0), a2, voffA); \
            PG8_WAIT_V(WFRESH); PG8_WAIT_L(0); PG8_BAR; PG8_MMA(1, 0, At, B0); PG8_MMA(1, 1, At, B1); PG8_BAR; PG8_SCHED; \
            PG8_LDB(B0, 1, 0); PG8_LDB(B1, 1, 1); PG8_SCHED; PG8_LDA(At, 1, 0); PG8_STAGE(PG8_SA(0, 1), a2 + hstepA, voffA); \
            PG8_WAIT_V(WFRESH); PG8_WAIT_L(0); PG8_BAR; PG8_MMA(0, 0, At, B0); PG8_MMA(0, 1, At, B1); PG8_BAR; PG8_SCHED; \
            PG8_LDA(At, 1, 1); PG8_STAGE(PG8_SB(1, 0), b3, voffB); PG8_STAGE(PG8_SB(1, 1), b3 + hstepB, voffB); PG8_STAGE(PG8_SA(1, 0), a3, voffA); \
            PG8_WAIT_V(8); PG8_WAIT_L(0); PG8_BAR; PG8_MMA(1, 0, At, B0); PG8_MMA(1, 1, At, B1); PG8_BAR; PG8_SCHED; \
        } while (0)
        int t = 0;
        if (RELAX_BOUNDARY && ui > 0) { PG8_TRIP(0, 24, false); t = 2; }
        for (; t < nt; t += 2) PG8_TRIP(t, 8, true);
#undef PG8_TRIP
        if constexpr (ALIGN_EPI) { if (wr == 0) PG8_BAR; }
        if (RELAX_BOUNDARY && has_next) PG8_STAGE(PG8_SA(1, 1), nA + kstep + hstepA, voffA);
        E(acc, cur, wr, wc, fr, fq);
        if (!has_next) break;
#pragma unroll
        for (int a = 0; a < 2; ++a)
#pragma unroll
            for (int b = 0; b < 2; ++b)
#pragma unroll
                for (int m = 0; m < 4; ++m)
#pragma unroll
                    for (int n = 0; n < 2; ++n) acc[a][b][m][n] = (f32x4){0.f, 0.f, 0.f, 0.f};
        cur = nxt; cA = nA; cB = nB; nt = cur.kind ? g.nt1 : g.nt0; ++ui;
        if constexpr (ALIGN_EPI) { if (wr == 1) PG8_BAR; }
    }
    PG8_WAIT_V(0);
    if constexpr (!ALIGN_EPI) { if (wr == 0) PG8_BAR; }
    PG8_BAR;
#undef PG8_SA
#undef PG8_SB
#undef PG8_STAGE
#undef PG8_LDA
#undef PG8_LDB
#undef PG8_MMA
#undef PG8_WAIT_V
#undef PG8_WAIT_L
#undef PG8_BAR
#undef PG8_SCHED
}

#define EPI_ROWS_BEGIN  _Pragma("unroll") for (int ai = 0; ai < 2; ++ai) _Pragma("unroll") for (int m = 0; m < 4; ++m) { const int r = u.pm * BM + ai * HALF + wr * 64 + m * 16 + fr; _Pragma("unroll") for (int bj = 0; bj < 2; ++bj) { \
        const f32x4 v0 = acc[ai][bj][m][0], v1 = acc[ai][bj][m][1]; const int c0 = u.pn * BM + bj * HALF + wc * 32 + fq * 8; (void)r; (void)c0;
#define EPI_ROWS_END } }
__device__ __forceinline__ u32x4 pack8(f32x4 a, f32x4 b) { u32x4 w; w.x = cvtpk(a[0], a[1]); w.y = cvtpk(a[2], a[3]); w.z = cvtpk(b[0], b[1]); w.w = cvtpk(b[2], b[3]); return w; }

struct EpiP1 {
    bf16_t *Q, *K, *V, *U, *Z, *GA, *GB; f32x2* zst; const LAS float* invf;
    __device__ __forceinline__ void operator()(const f32x4 (&acc)[2][2][4][2], const Unit& u, int wr, int wc, int fr, int fq) const {
        const int pn = u.pn;
        if (pn < 6) {
            bf16_t* O = pn < 3 ? Q : K; const int cb = pn < 3 ? 0 : AW; const float sc = pn < 3 ? QSCALE : 1.0f;
            const int i0 = (wc & 1) * 16 + fq * 4;
            const f32x4 fr4 = *(const LAS f32x4*)(invf + i0);
#pragma unroll
          for (int ai = 0; ai < 2; ++ai)
#pragma unroll
            for (int m = 0; m < 4; ++m) { const int r = u.pm * BM + ai * HALF + wr * 64 + m * 16 + fr;
                const float pos = (float)(r & (SEQ - 1)); f32x4 t0, t1;
                { const float a0 = pos * fr4[0], a1 = pos * fr4[1], a2 = pos * fr4[2], a3 = pos * fr4[3];
                  const float r0 = __builtin_amdgcn_fractf(a0 * 0.15915494309189535f), r1 = __builtin_amdgcn_fractf(a1 * 0.15915494309189535f), r2 = __builtin_amdgcn_fractf(a2 * 0.15915494309189535f), r3 = __builtin_amdgcn_fractf(a3 * 0.15915494309189535f);
                  t0[0] = __builtin_amdgcn_cosf(r0); t0[1] = __builtin_amdgcn_sinf(r0); t0[2] = __builtin_amdgcn_cosf(r1); t0[3] = __builtin_amdgcn_sinf(r1);
                  t1[0] = __builtin_amdgcn_cosf(r2); t1[1] = __builtin_amdgcn_sinf(r2); t1[2] = __builtin_amdgcn_cosf(r3); t1[3] = __builtin_amdgcn_sinf(r3); }
#pragma unroll
              for (int bj = 0; bj < 2; ++bj) { const f32x4 v0 = acc[ai][bj][m][0], v1 = acc[ai][bj][m][1]; const int c0 = u.pn * BM + bj * HALF + wc * 32 + fq * 8;
                f32x4 o0, o1;
                o0[0] = (v0[0] * t0[0] - v0[1] * t0[1]) * sc; o0[1] = (v0[1] * t0[0] + v0[0] * t0[1]) * sc;
                o0[2] = (v0[2] * t0[2] - v0[3] * t0[3]) * sc; o0[3] = (v0[3] * t0[2] + v0[2] * t0[3]) * sc;
                o1[0] = (v1[0] * t1[0] - v1[1] * t1[1]) * sc; o1[1] = (v1[1] * t1[0] + v1[0] * t1[1]) * sc;
                o1[2] = (v1[2] * t1[2] - v1[3] * t1[3]) * sc; o1[3] = (v1[3] * t1[2] + v1[2] * t1[3]) * sc;
                *(u32x4*)(O + hrow(r >> 13, r & (SEQ - 1), (c0 - cb) >> 6) * 64 + ((c0 - cb) & 63)) = pack8(o0, o1);
              } }
        } else if (pn < 9) {
            EPI_ROWS_BEGIN
                *(u32x4*)(V + hrow(r >> 13, r & (SEQ - 1), (c0 - 2 * AW) >> 6) * 64 + ((c0 - 2 * AW) & 63)) = pack8(v0, v1);
            EPI_ROWS_END
        } else if (pn < 11) {
            EPI_ROWS_BEGIN
                f32x4 o0, o1;
#pragma unroll
                for (int e = 0; e < 4; ++e) { o0[e] = gelu_tanh(v0[e]); o1[e] = gelu_tanh(v1[e]); }
                *(u32x4*)(U + (size_t)r * GW + (c0 - 3 * AW)) = pack8(o0, o1);
            EPI_ROWS_END
        } else if (pn < 13) {
#pragma unroll
            for (int ai = 0; ai < 2; ++ai)
#pragma unroll
                for (int m = 0; m < 4; ++m) { const int r = u.pm * BM + ai * HALF + wr * 64 + m * 16 + fr; float s = 0.f, q = 0.f;
#pragma unroll
                    for (int bj = 0; bj < 2; ++bj) { const f32x4 v0 = acc[ai][bj][m][0], v1 = acc[ai][bj][m][1]; const int c0 = u.pn * BM + bj * HALF + wc * 32 + fq * 8;
                        f32x4 o0, o1;
#pragma unroll
                        for (int e = 0; e < 4; ++e) { o0[e] = gelu_tanh(v0[e]); o1[e] = gelu_tanh(v1[e]); s += o0[e] + o1[e]; q += o0[e] * o0[e] + o1[e] * o1[e]; }
                        *(u32x4*)(Z + (size_t)r * GW + (c0 - 3 * AW - GW)) = pack8(o0, o1); }
                    s += __shfl_xor(s, 16); s += __shfl_xor(s, 32); q += __shfl_xor(q, 16); q += __shfl_xor(q, 32);
                    if (fq == 0) zst[(size_t)r * 8 + (pn - 11) * 4 + wc] = (f32x2){s, q}; }
        } else {
            bf16_t* O = pn < 17 ? GA : GB; const int cb = pn < 17 ? (3 * AW + 2 * GW) : (3 * AW + 2 * GW + DM);
            EPI_ROWS_BEGIN
                f32x4 o0, o1;
#pragma unroll
                for (int e = 0; e < 4; ++e) { o0[e] = sigmoidf_(v0[e]); o1[e] = sigmoidf_(v1[e]); }
                *(u32x4*)(O + (size_t)r * DM + (c0 - cb)) = pack8(o0, o1);
            EPI_ROWS_END
        }
    }
};
struct EpiMerge {
    const bf16_t *GA, *GB; bf16_t* MG;
    __device__ __forceinline__ void operator()(const f32x4 (&acc)[2][2][4][2], const Unit& u, int wr, int wc, int fr, int fq) const {
        if (u.kind == 0) {
            EPI_ROWS_BEGIN
                const u32x4 gw = *(const u32x4*)(GA + (size_t)r * DM + c0);
                f32x4 o0, o1; o0[0] = v0[0] * bflo(gw.x); o0[1] = v0[1] * bfhi(gw.x); o0[2] = v0[2] * bflo(gw.y); o0[3] = v0[3] * bfhi(gw.y);
                o1[0] = v1[0] * bflo(gw.z); o1[1] = v1[1] * bfhi(gw.z); o1[2] = v1[2] * bflo(gw.w); o1[3] = v1[3] * bfhi(gw.w);
                *(u32x4*)(MG + (size_t)r * DM + c0) = pack8(o0, o1);
            EPI_ROWS_END
        } else {
            EPI_ROWS_BEGIN
                const u32x4 gw = *(const u32x4*)(GB + (size_t)r * DM + c0); const u32x4 pw = *(const u32x4*)(MG + (size_t)r * DM + c0);
                f32x4 o0, o1; o0[0] = bflo(pw.x) + v0[0] * bflo(gw.x); o0[1] = bfhi(pw.x) + v0[1] * bfhi(gw.x); o0[2] = bflo(pw.y) + v0[2] * bflo(gw.y); o0[3] = bfhi(pw.y) + v0[3] * bfhi(gw.y);
                o1[0] = bflo(pw.z) + v1[0] * bflo(gw.z); o1[1] = bfhi(pw.z) + v1[1] * bfhi(gw.z); o1[2] = bflo(pw.w) + v1[2] * bflo(gw.w); o1[3] = bfhi(pw.w) + v1[3] * bfhi(gw.w);
                *(u32x4*)(MG + (size_t)r * DM + c0) = pack8(o0, o1);
            EPI_ROWS_END
        }
    }
};
struct EpiYss {
    bf16_t* Y; float* ss;
    __device__ __forceinline__ void operator()(const f32x4 (&acc)[2][2][4][2], const Unit& u, int wr, int wc, int fr, int fq) const {
#pragma unroll
        for (int ai = 0; ai < 2; ++ai)
#pragma unroll
            for (int m = 0; m < 4; ++m) { const int r = u.pm * BM + ai * HALF + wr * 64 + m * 16 + fr; float q = 0.f;
#pragma unroll
                for (int bj = 0; bj < 2; ++bj) { const f32x4 v0 = acc[ai][bj][m][0], v1 = acc[ai][bj][m][1]; const int c0 = u.pn * BM + bj * HALF + wc * 32 + fq * 8;
#pragma unroll
                    for (int e = 0; e < 4; ++e) q += v0[e] * v0[e] + v1[e] * v1[e];
                    *(u32x4*)(Y + (size_t)r * DM + c0) = pack8(v0, v1); }
                q += __shfl_xor(q, 16); q += __shfl_xor(q, 32);
                if (fq == 0) ss[(size_t)r * 16 + u.pn * 4 + wc] = q; }
    }
};
struct EpiRelu2 {
    bf16_t* H;
    __device__ __forceinline__ void operator()(const f32x4 (&acc)[2][2][4][2], const Unit& u, int wr, int wc, int fr, int fq) const {
        EPI_ROWS_BEGIN
            f32x4 o0, o1;
#pragma unroll
            for (int e = 0; e < 4; ++e) { const float a = fmaxf(v0[e], 0.f), b = fmaxf(v1[e], 0.f); o0[e] = a * a; o1[e] = b * b; }
            *(u32x4*)(H + (size_t)r * DFF + c0) = pack8(o0, o1);
        EPI_ROWS_END
    }
};
}

constexpr size_t MiB = 1u << 20;
constexpr size_t WS_CTL = 0, CTL_ZERO_BYTES = 64 * 1024;
constexpr size_t WS_WIN = 1 * MiB, WS_WCAT = 12 * MiB, WS_WOUT = 14 * MiB, WS_WMI = 16 * MiB, WS_WMO = 24 * MiB, WS_WSP = 32 * MiB, WS_ROPE = 33 * MiB;
constexpr size_t WS_ZST = 36 * MiB, WS_SS1 = 40 * MiB, WS_SS2 = 44 * MiB;
constexpr size_t WS_XB = 48 * MiB;
constexpr size_t WS_RS0 = 35 * MiB, WS_RS2 = 35 * MiB + 512 * 1024;
constexpr size_t WS_YC = 304 * MiB;
constexpr size_t WS_Y2 = 723 * MiB;
constexpr size_t WS_Q = 176 * MiB, WS_K = 272 * MiB + 80 * 1024, WS_V = 368 * MiB + 176 * 1024, WS_U = 465 * MiB, WS_Z = 529 * MiB + 48 * 1024, WS_GA = 594 * MiB, WS_GB = 722 * MiB + 112 * 1024, WS_OG = 851 * MiB + 16 * 1024, WS_LSE = 948 * MiB;
constexpr size_t WS_MG = 176 * MiB;
constexpr size_t WS_Y = 465 * MiB;
constexpr size_t WS_H = 176 * MiB;
constexpr size_t WS_END = 952 * MiB;
constexpr int CW_BAR = 1024;

constexpr int RING_BYTES = 131072, LDSCTL_OFF = RING_BYTES, MISC_OFF = LDSCTL_OFF + 320, INVF_OFF = LDSCTL_OFF + 1024, LDS_BYTES = 147456;

#define XB_TMO      128
#define XB_XCNT(j)  (256  + 64 * (j))
#define XB_XSUB(j)  (1280 + 64 * (j))
#define XB_XGEN(j)  (2304 + 64 * (j))
#define XB_TOP      3328
#define XB_TOPGEN   3392
#define XCD_BAR_WORDS 3456
#define XB_SPIN_CAP (1u << 22)
__device__ __forceinline__ unsigned xb_ld(unsigned* p)              { return __hip_atomic_load(p, __ATOMIC_RELAXED, __HIP_MEMORY_SCOPE_AGENT); }
__device__ __forceinline__ unsigned xb_add(unsigned* p, unsigned v) { return __hip_atomic_fetch_add(p, v, __ATOMIC_RELAXED, __HIP_MEMORY_SCOPE_AGENT); }
__device__ __forceinline__ unsigned xb_xcc_id() { return (unsigned)__builtin_amdgcn_s_getreg((3 << 11) | 20) & 0xFu; }
#define XB_SPIN(cond, bar) do { unsigned _sp = 0; while (cond) { __builtin_amdgcn_s_sleep(1); \
    if ((++_sp & 255u) == 0u) { if (xb_ld(&(bar)[XB_TMO])) break; if (_sp > XB_SPIN_CAP) { atomicAdd(&(bar)[XB_TMO], 1u); break; } } } } while (0)
struct XcdBarrier { unsigned* bar; unsigned x; volatile LAS unsigned* st; };
__device__ __forceinline__ XcdBarrier xcd_barrier_post(unsigned* bar, volatile LAS unsigned* st) {
    XcdBarrier b; b.bar = bar; b.x = xb_xcc_id(); b.st = st;
    if (threadIdx.x == 0) (void)xb_add(&bar[XB_XCNT(b.x)], 1u);
    return b;
}
__device__ __forceinline__ void xcd_barrier_complete(unsigned* bar, unsigned x, unsigned& nloc, unsigned& nx) {
    const unsigned G = gridDim.x * gridDim.y * gridDim.z;
    unsigned sum, cnt, mine, sp = 0u;
    for (;;) {
        sum = 0u; cnt = 0u; mine = 0u;
#pragma unroll
        for (unsigned j = 0; j < 16; ++j) { const unsigned c = xb_ld(&bar[XB_XCNT(j)]); sum += c; cnt += (c > 0u) ? 1u : 0u; mine = (j == x) ? c : mine; }
        if (sum == G) break;
        __builtin_amdgcn_s_sleep(1);
        if ((++sp & 255u) == 0u) { if (xb_ld(&bar[XB_TMO])) break; if (sp > XB_SPIN_CAP) { atomicAdd(&bar[XB_TMO], 1u); break; } }
    }
    nloc = mine > 0u ? mine : 1u; nx = cnt > 0u ? cnt : 1u;
}
__device__ __forceinline__ void xcd_barrier(const XcdBarrier& b) {
    asm volatile("s_waitcnt vmcnt(0)" ::: "memory");
    __syncthreads();
    if (threadIdx.x == 0) {
        unsigned* bar = b.bar;
        __builtin_amdgcn_s_waitcnt(0);
        unsigned nloc = b.st[0], nx = b.st[1];
        if (nloc == 0u) { xcd_barrier_complete(bar, b.x, nloc, nx); b.st[0] = nloc; b.st[1] = nx; }
        const unsigned old = xb_add(&bar[XB_XSUB(b.x)], 1u);
        const unsigned gen = old / nloc;
        if (old + 1u == (gen + 1u) * nloc) {
            __builtin_amdgcn_fence(__ATOMIC_RELEASE, "agent");
            asm volatile("s_waitcnt vmcnt(0)" ::: "memory");
            const unsigned og = xb_add(&bar[XB_TOP], 1u);
            const unsigned tg = og / nx;
            if (og + 1u == (tg + 1u) * nx) xb_add(&bar[XB_TOPGEN], 1u);
            else XB_SPIN(xb_ld(&bar[XB_TOPGEN]) == tg, bar);
            __builtin_amdgcn_fence(__ATOMIC_ACQUIRE, "agent");
            xb_add(&bar[XB_XGEN(b.x)], 1u);
            asm volatile("s_waitcnt vmcnt(0)" ::: "memory");
        } else {
            XB_SPIN(xb_ld(&bar[XB_XGEN(b.x)]) == gen, bar);
            __builtin_amdgcn_fence(__ATOMIC_ACQUIRE, "agent");
            asm volatile("s_waitcnt vmcnt(0)" ::: "memory");
        }
    }
    __syncthreads();
}

constexpr int NWAVES = 8;
struct Args { const float* in[15]; float* out; unsigned char* ws; int ph_lo, ph_hi; };
struct Frame { LAS unsigned char* lds; int tid, lane, wave, vcu, G; };

__device__ __forceinline__ float wave_sum(float v) {
#pragma unroll
    for (int o = 1; o < 64; o <<= 1) v += __shfl_xor(v, o);
    return v;
}

__constant__ float c_invfreq[32] = {1.000000000e+00f, 7.498942614e-01f, 5.623413324e-01f, 4.216965139e-01f, 3.162277639e-01f, 2.371373773e-01f, 1.778279394e-01f, 1.333521307e-01f,
    1.000000015e-01f, 7.498941571e-02f, 5.623413250e-02f, 4.216965288e-02f, 3.162277490e-02f, 2.371373773e-02f, 1.778279431e-02f, 1.333521493e-02f,
    9.999999776e-03f, 7.498941850e-03f, 5.623413250e-03f, 4.216964822e-03f, 3.162277630e-03f, 2.371373586e-03f, 1.778279431e-03f, 1.333521446e-03f,
    1.000000047e-03f, 7.498942432e-04f, 5.623413017e-04f, 4.216965172e-04f, 3.162277571e-04f, 2.371373703e-04f, 1.778279402e-04f, 1.333521504e-04f};

__device__ __forceinline__ void p0_transpose_item(const float* W, int N, bf16_t* WT, int ldd, int koff, bool qkperm, const float* kgain, LAS float* scr, int kb, int nb, int lane) {
    const int k0 = 64 * kb, n0 = 32 * nb;
    int nd = n0 + (lane & 31), nsrc = nd;
    if (qkperm) { const int dp = nd & 63; nsrc = (nd & ~63) + ((dp & 1) ? 32 + (dp >> 1) : (dp >> 1)); }
#pragma unroll 8
    for (int i = 0; i < 32; ++i) { const int kk = 2 * i + (lane >> 5); const float gk = kgain ? kgain[k0 + kk] : 1.0f; scr[kk * 33 + (lane & 31)] = W[(size_t)(k0 + kk) * N + nsrc] * gk; }
    asm volatile("s_waitcnt lgkmcnt(0)" ::: "memory");
    const int c = lane & 7;
#pragma unroll
    for (int j = 0; j < 4; ++j) { const int n = (lane >> 3) + 8 * j; const LAS float* s = scr + (8 * c) * 33 + n;
        u32x4 o; o.x = cvtpk(s[0 * 33], s[1 * 33]); o.y = cvtpk(s[2 * 33], s[3 * 33]); o.z = cvtpk(s[4 * 33], s[5 * 33]); o.w = cvtpk(s[6 * 33], s[7 * 33]);
        *(u32x4*)(WT + (size_t)(n0 + n) * ldd + koff + k0 + 8 * c) = o; }
    asm volatile("s_waitcnt lgkmcnt(0)" ::: "memory");
}

__device__ __forceinline__ void p0_prologue(const Frame& F, const Args& a) {
    unsigned char* ws = a.ws;
    LAS float* scr = (LAS float*)(F.lds + F.wave * 16384);
    const int gw = F.vcu * NWAVES + F.wave, NGW = F.G * NWAVES;
    const float* w_in = a.in[2]; const float* w_ba = a.in[7]; const float* w_bg = a.in[8]; const float* w_out = a.in[9]; const float* w_mi = a.in[12]; const float* w_mo = a.in[13];
    constexpr int I_IN = (DM / 64) * (INW / 32), I_BA = (AOW / 64) * (DM / 32), I_BG = (GW / 64) * (DM / 32), I_OUT = (DM / 64) * (DM / 32), I_MI = (DM / 64) * (DFF / 32), I_MO = (DFF / 64) * (DM / 32);
    constexpr int NITEMS = I_IN + I_BA + I_BG + I_OUT + I_MI + I_MO;
    for (int it = gw; it < NITEMS; it += NGW) {
        int r = it;
        if (r < I_IN) { const int nblk = INW / 32, kb = r / nblk, nb = r % nblk; p0_transpose_item(w_in, INW, (bf16_t*)(ws + WS_WIN), DM, 0, nb < (2 * AW / 32), a.in[1], scr, kb, nb, F.lane); continue; } r -= I_IN;
        if (r < I_BA) { const int nblk = DM / 32, kb = r / nblk, nb = r % nblk; p0_transpose_item(w_ba, DM, (bf16_t*)(ws + WS_WCAT), AOW + GW, 0, false, nullptr, scr, kb, nb, F.lane); continue; } r -= I_BA;
        if (r < I_BG) { const int nblk = DM / 32, kb = r / nblk, nb = r % nblk; p0_transpose_item(w_bg, DM, (bf16_t*)(ws + WS_WCAT), AOW + GW, AOW, false, nullptr, scr, kb, nb, F.lane); continue; } r -= I_BG;
        if (r < I_OUT) { const int nblk = DM / 32, kb = r / nblk, nb = r % nblk; p0_transpose_item(w_out, DM, (bf16_t*)(ws + WS_WOUT), DM, 0, false, nullptr, scr, kb, nb, F.lane); continue; } r -= I_OUT;
        if (r < I_MI) { const int nblk = DFF / 32, kb = r / nblk, nb = r % nblk; p0_transpose_item(w_mi, DFF, (bf16_t*)(ws + WS_WMI), DM, 0, false, a.in[11], scr, kb, nb, F.lane); continue; } r -= I_MI;
        { const int nblk = DM / 32, kb = r / nblk, nb = r % nblk; p0_transpose_item(w_mo, DM, (bf16_t*)(ws + WS_WMO), DFF, 0, false, nullptr, scr, kb, nb, F.lane); }
    }
    const int gt = F.vcu * (NWAVES * 64) + F.tid, NGT = F.G * NWAVES * 64;
    { const float* wsp = a.in[3]; bf16_t* o = (bf16_t*)(ws + WS_WSP);
      for (int e = gt; e < 4 * 128 * 128 / 2; e += NGT) { const int i = (e >> 6) & 127, j = (e & 63) * 2; const f32x2 w = *(const f32x2*)(wsp + 2 * (size_t)e);
          *(unsigned*)(o + 2 * (size_t)e) = cvtpk(j <= i ? w.x : 0.f, (j + 1) <= i ? w.y : 0.f); } }
    { const float* x = a.in[0]; bf16_t* XB = (bf16_t*)(ws + WS_XB); float* INV0 = (float*)(ws + WS_RS0);
      f32x4 v[4], nx[4];
      if (gw < MROWS) { const f32x4* xr = (const f32x4*)(x + (size_t)gw * DM) + F.lane;
#pragma unroll
          for (int j = 0; j < 4; ++j) nx[j] = xr[64 * j]; }
      for (int m = gw; m < MROWS; m += NGW) {
#pragma unroll
          for (int j = 0; j < 4; ++j) v[j] = nx[j];
          if (m + NGW < MROWS) { const f32x4* xr = (const f32x4*)(x + (size_t)(m + NGW) * DM) + F.lane;
#pragma unroll
              for (int j = 0; j < 4; ++j) nx[j] = xr[64 * j]; }
          float s = 0.f;
#pragma unroll
          for (int j = 0; j < 4; ++j) s += (v[j].x * v[j].x + v[j].y * v[j].y) + (v[j].z * v[j].z + v[j].w * v[j].w);
          const float ms = wave_sum(s) * (1.f / DM) + EPS; const float rs = 1.0f / sqrtf(ms);
          u32x2* o8 = (u32x2*)(XB + (size_t)m * DM) + F.lane;
#pragma unroll
          for (int j = 0; j < 4; ++j) o8[64 * j] = (u32x2){cvtpk(v[j].x * rs, v[j].y * rs), cvtpk(v[j].z * rs, v[j].w * rs)};
          if (F.lane == 0) INV0[m] = sqrtf(ms);
      } }
}

constexpr int KP = 72;
constexpr int ATT_KS = 0, ATT_VS = 384 * KP * 2;
typedef short v4i16_t __attribute__((ext_vector_type(4)));
__device__ __forceinline__ f32x4 mfma16(bf16x8 a, bf16x8 b, f32x4 c) { return __builtin_amdgcn_mfma_f32_16x16x32_bf16(a, b, c, 0, 0, 0); }
__device__ __forceinline__ s16x4 ldtr(const LAS unsigned char* p) { return __builtin_bit_cast(s16x4, __builtin_amdgcn_ds_read_tr16_b64_v4i16((LAS v4i16_t*)p)); }
struct AttDU { size_t rowb; int np; };
__device__ __forceinline__ AttDU att_decode(int du) {
    AttDU u; const int bh = du >> 5, idx = du & 31, h = bh % 12; const int dl = (h >> 2) * 2; const int nper = (SEQ >> dl) >> 8;
    const int r = idx / nper; u.np = idx % nper; u.rowb = (size_t)bh * SEQ + (size_t)r * (SEQ >> dl) + 256 * u.np; return u;
}
__device__ __forceinline__ void att_load(const AttDU& u, const bf16_t* Q, const bf16_t* K, const bf16_t* V, int tid, int wave, int l15, int g4, u32x4 (&kr)[6], u32x4 (&vr)[6], bf16x8 (&qf)[2][2]) {
#pragma unroll
    for (int it = 0; it < 6; ++it) { const int p = tid + 512 * it, key = p >> 3, ch = p & 7; kr[it] = (u32x4){0u, 0u, 0u, 0u}; vr[it] = (u32x4){0u, 0u, 0u, 0u};
        if (u.np > 0 || key >= 128) { const size_t off = (u.rowb + key - 128) * 64 + ch * 8; kr[it] = *(const u32x4*)(K + off); vr[it] = *(const u32x4*)(V + off); } }
#pragma unroll
    for (int tt = 0; tt < 2; ++tt) { const size_t qrow = u.rowb + 16 * (2 * wave + tt) + l15;
#pragma unroll
        for (int ks = 0; ks < 2; ++ks) qf[tt][ks] = *(const bf16x8*)(Q + qrow * 64 + ks * 32 + g4 * 8); }
}
__device__ __forceinline__ void attn_phase(const Frame& F, const Args& a) {
    unsigned char* ws = a.ws;
    const bf16_t* Q = (const bf16_t*)(ws + WS_Q); const bf16_t* K = (const bf16_t*)(ws + WS_K); const bf16_t* V = (const bf16_t*)(ws + WS_V);
    bf16_t* OG = (bf16_t*)(ws + WS_OG); float* LSE = (float*)(ws + WS_LSE);
    LAS unsigned char* Ks = F.lds + ATT_KS; LAS unsigned char* Vs = F.lds + ATT_VS;
    const int l15 = F.lane & 15, g4 = F.lane >> 4;
    constexpr int NDU = BATCH * 12 * 32;
    for (int e = F.tid; e < 16 * KP / 2; e += 512) *(LAS unsigned*)(Vs + 384 * KP * 2 + e * 4) = 0u;
    u32x4 kr[6], vr[6]; bf16x8 qn[2][2];
    int du = F.vcu;
    AttDU u = att_decode(du < NDU ? du : 0);
    if (du < NDU) att_load(u, Q, K, V, F.tid, F.wave, l15, g4, kr, vr, qn);
    for (; du < NDU; du += F.G) {
#pragma unroll
        for (int it = 0; it < 6; ++it) { const int p = F.tid + 512 * it, key = p >> 3, ch = p & 7;
            *(LAS u32x4*)(Ks + (key * KP + ch * 8) * 2) = kr[it]; *(LAS u32x4*)(Vs + (key * KP + ch * 8) * 2) = vr[it]; }
        bf16x8 qf[2][2];
#pragma unroll
        for (int tt = 0; tt < 2; ++tt)
#pragma unroll
            for (int ks = 0; ks < 2; ++ks) qf[tt][ks] = qn[tt][ks];
        const AttDU cu = u;
        const int dn = du + F.G;
        if (dn < NDU) { u = att_decode(dn); att_load(u, Q, K, V, F.tid, F.wave, l15, g4, kr, vr, qn); }
        __syncthreads();
#ifdef ATT_CREP
        for (int crep_ = 0; crep_ < ATT_CREP; ++crep_)
#endif
        {
            const int t0 = 2 * F.wave;
            const size_t qrow0 = cu.rowb + 16 * t0 + l15;
            f32x4 s[2][9];
#pragma unroll
            for (int tt = 0; tt < 2; ++tt) {
                const LAS unsigned char* kb = Ks + ((16 * (t0 + tt) + l15) * KP + g4 * 8) * 2;
                bf16x8 kf[9];
#pragma unroll
                for (int kt = 0; kt < 9; ++kt) kf[kt] = *(const LAS bf16x8*)(kb + kt * 16 * KP * 2);
#pragma unroll
                for (int kt = 0; kt < 9; ++kt) s[tt][kt] = mfma16(kf[kt], qf[tt][0], (f32x4){0.f, 0.f, 0.f, 0.f});
#pragma unroll
                for (int kt = 0; kt < 9; ++kt) kf[kt] = *(const LAS bf16x8*)(kb + kt * 16 * KP * 2 + 64);
#pragma unroll
                for (int kt = 0; kt < 9; ++kt) s[tt][kt] = mfma16(kf[kt], qf[tt][1], s[tt][kt]);
            }
            float mx[2], sum[2], inv[2];
#pragma unroll
            for (int tt = 0; tt < 2; ++tt) {
                const int t = t0 + tt;
#pragma unroll
                for (int e = 0; e < 4; ++e) { s[tt][0][e] = (4 * g4 + e >= l15) ? s[tt][0][e] : -1.0e30f; s[tt][8][e] = (4 * g4 + e <= l15) ? s[tt][8][e] : -1.0e30f; }
                if (cu.np == 0) {
#pragma unroll
                    for (int kt = 0; kt < 8; ++kt) if (t + kt < 8) s[tt][kt] = (f32x4){-1.0e30f, -1.0e30f, -1.0e30f, -1.0e30f};
                }
                float m = -3.0e38f;
#pragma unroll
                for (int kt = 0; kt < 9; ++kt) m = fmaxf(fmaxf(m, fmaxf(s[tt][kt][0], s[tt][kt][1])), fmaxf(s[tt][kt][2], s[tt][kt][3]));
                mx[tt] = m;
            }
#pragma unroll
            for (int tt = 0; tt < 2; ++tt) { mx[tt] = fmaxf(mx[tt], __shfl_xor(mx[tt], 16)); }
#pragma unroll
            for (int tt = 0; tt < 2; ++tt) { mx[tt] = fmaxf(mx[tt], __shfl_xor(mx[tt], 32)); }
#pragma unroll
            for (int tt = 0; tt < 2; ++tt) { float sm = 0.f;
#pragma unroll
                for (int kt = 0; kt < 9; ++kt)
#pragma unroll
                    for (int e = 0; e < 4; ++e) { s[tt][kt][e] = __builtin_amdgcn_exp2f(s[tt][kt][e] - mx[tt]); sm += s[tt][kt][e]; }
                sum[tt] = sm; }
#pragma unroll
            for (int tt = 0; tt < 2; ++tt) sum[tt] += __shfl_xor(sum[tt], 16);
#pragma unroll
            for (int tt = 0; tt < 2; ++tt) { sum[tt] += __shfl_xor(sum[tt], 32); inv[tt] = 1.0f / sum[tt]; }
#pragma unroll
            for (int tt = 0; tt < 2; ++tt) {
                const int t = t0 + tt;
                bf16x8 pf[5];
#pragma unroll
                for (int s5 = 0; s5 < 5; ++s5) { u32x4 w; w.x = cvtpk(s[tt][2 * s5][0], s[tt][2 * s5][1]); w.y = cvtpk(s[tt][2 * s5][2], s[tt][2 * s5][3]);
                    if (s5 < 4) { w.z = cvtpk(s[tt][2 * s5 + 1][0], s[tt][2 * s5 + 1][1]); w.w = cvtpk(s[tt][2 * s5 + 1][2], s[tt][2 * s5 + 1][3]); } else { w.z = 0u; w.w = 0u; }
                    pf[s5] = __builtin_bit_cast(bf16x8, w); }
                f32x4 o[4];
#pragma unroll
                for (int dt = 0; dt < 4; ++dt) o[dt] = (f32x4){0.f, 0.f, 0.f, 0.f};
                {
                    const LAS unsigned char* vb = Vs + ((16 * t + 4 * g4 + (l15 >> 2)) * KP + 4 * (l15 & 3)) * 2;
#pragma unroll
                    for (int s5 = 0; s5 < 5; ++s5) { s16x4 lo[4], hi[4];
#pragma unroll
                        for (int dt = 0; dt < 4; ++dt) { lo[dt] = ldtr(vb + (32 * s5 * KP + 16 * dt) * 2); hi[dt] = ldtr(vb + ((32 * s5 + 16) * KP + 16 * dt) * 2); }
#pragma unroll
                        for (int dt = 0; dt < 4; ++dt) o[dt] = mfma16(__builtin_shufflevector(lo[dt], hi[dt], 0, 1, 2, 3, 4, 5, 6, 7), pf[s5], o[dt]); } }
                const size_t qrow = qrow0 + 16 * tt;
#pragma unroll
                for (int dt = 0; dt < 4; ++dt) *(u32x2*)(OG + qrow * 64 + 16 * dt + 4 * g4) = (u32x2){cvtpk(o[dt][0] * inv[tt], o[dt][1] * inv[tt]), cvtpk(o[dt][2] * inv[tt], o[dt][3] * inv[tt])};
                if (g4 == 0) LSE[qrow] = mx[tt] + __builtin_amdgcn_logf(sum[tt]);
            }
        }
        __syncthreads();
    }
}

constexpr int ZP = 136;
__device__ __forceinline__ void gmlp_phase(const Frame& F, const Args& a) {
    unsigned char* ws = a.ws;
    const bf16_t* U = (const bf16_t*)(ws + WS_U); const bf16_t* Z = (const bf16_t*)(ws + WS_Z); const f32x2* zst = (const f32x2*)(ws + WS_ZST);
    const bf16_t* Wsp = (const bf16_t*)(ws + WS_WSP); bf16_t* YC = (bf16_t*)(ws + WS_YC);
    const float* bsp = a.in[4]; const float* lng = a.in[5]; const float* lnb = a.in[6];
    LAS unsigned char* Zs = F.lds; LAS f32x2* st = (LAS f32x2*)(F.lds + 128 * ZP * 2);
    const int l15 = F.lane & 15, g4 = F.lane >> 4, w = F.wave;
    constexpr int NUN = (MROWS / 128) * 4;
    u32x4 zr[4]; f32x2 sr = {0.f, 0.f};
    int un = F.vcu;
#define GM_LOAD(unit) do { const int c_ = (unit) >> 2, grp_ = (unit) & 3; const size_t tok0_ = (size_t)c_ * 128; \
        _Pragma("unroll") for (int it = 0; it < 4; ++it) { const int p = F.tid + 512 * it, j = p >> 4, c8 = p & 15; zr[it] = *(const u32x4*)(Z + (tok0_ + j) * GW + grp_ * 128 + c8 * 8); } \
        if (F.tid < 128) { const f32x4* p4 = (const f32x4*)(zst + (tok0_ + F.tid) * 8); float s_ = 0.f, q_ = 0.f; \
            _Pragma("unroll") for (int e = 0; e < 4; ++e) { const f32x4 v = p4[e]; s_ += v.x + v.z; q_ += v.y + v.w; } \
            const float mean = s_ * (1.f / GW), var = fmaxf(q_ * (1.f / GW) - mean * mean, 0.f); sr = (f32x2){mean, 1.0f / sqrtf(var + EPS)}; } } while (0)
    if (un < NUN) GM_LOAD(un);
    for (; un < NUN; un += F.G) {
        const int c = un >> 2, grp = un & 3; const size_t tok0 = (size_t)c * 128;
        if (F.tid < 128) st[F.tid] = sr;
        __syncthreads();
#pragma unroll
        for (int it = 0; it < 4; ++it) { const int p = F.tid + 512 * it, j = p >> 4, c8 = p & 15; const u32x4 zv = zr[it];
            const f32x4 ga = *(const f32x4*)(lng + grp * 128 + c8 * 8), gb = *(const f32x4*)(lng + grp * 128 + c8 * 8 + 4);
            const f32x4 ba = *(const f32x4*)(lnb + grp * 128 + c8 * 8), bb = *(const f32x4*)(lnb + grp * 128 + c8 * 8 + 4);
            const f32x2 ms = st[j];
            u32x4 o;
            o.x = cvtpk((bflo(zv.x) - ms.x) * ms.y * ga[0] + ba[0], (bfhi(zv.x) - ms.x) * ms.y * ga[1] + ba[1]);
            o.y = cvtpk((bflo(zv.y) - ms.x) * ms.y * ga[2] + ba[2], (bfhi(zv.y) - ms.x) * ms.y * ga[3] + ba[3]);
            o.z = cvtpk((bflo(zv.z) - ms.x) * ms.y * gb[0] + bb[0], (bfhi(zv.z) - ms.x) * ms.y * gb[1] + bb[1]);
            o.w = cvtpk((bflo(zv.w) - ms.x) * ms.y * gb[2] + bb[2], (bfhi(zv.w) - ms.x) * ms.y * gb[3] + bb[3]);
            *(LAS u32x4*)(Zs + (j * ZP + c8 * 8) * 2) = o; }
        const int nu = un + F.G;
        if (nu < NUN) GM_LOAD(nu);
        __syncthreads();
        {
            bf16x8 wf[4];
#pragma unroll
            for (int ks = 0; ks < 4; ++ks) if (ks <= (w >> 1)) wf[ks] = *(const bf16x8*)(Wsp + ((size_t)(grp * 128 + 16 * w + l15)) * 128 + ks * 32 + g4 * 8);
            const int i = 16 * w + l15; const size_t tok = tok0 + i; const float bi = bsp[grp * 128 + i];
            f32x4 acc[8]; u32x2 uv[8];
#pragma unroll
            for (int mt = 0; mt < 8; ++mt) { acc[mt] = (f32x4){0.f, 0.f, 0.f, 0.f}; uv[mt] = *(const u32x2*)(U + tok * GW + grp * 128 + 16 * mt + 4 * g4); }
#pragma unroll
            for (int ks = 0; ks < 4; ++ks) if (ks <= (w >> 1)) {
                const LAS unsigned char* zb = Zs + ((32 * ks + 8 * g4 + (l15 >> 2)) * ZP + 4 * (l15 & 3)) * 2;
                s16x4 lo[8], hi[8];
#pragma unroll
                for (int mt = 0; mt < 8; ++mt) { lo[mt] = ldtr(zb + 16 * mt * 2); hi[mt] = ldtr(zb + (4 * ZP + 16 * mt) * 2); }
#pragma unroll
                for (int mt = 0; mt < 8; ++mt) acc[mt] = mfma16(__builtin_shufflevector(lo[mt], hi[mt], 0, 1, 2, 3, 4, 5, 6, 7), wf[ks], acc[mt]); }
#pragma unroll
            for (int mt = 0; mt < 8; ++mt) { const int ch = 16 * mt + 4 * g4;
                const float o0 = bflo(uv[mt].x) * (acc[mt][0] + bi), o1 = bfhi(uv[mt].x) * (acc[mt][1] + bi), o2 = bflo(uv[mt].y) * (acc[mt][2] + bi), o3 = bfhi(uv[mt].y) * (acc[mt][3] + bi);
                *(u32x2*)(YC + tok * (AOW + GW) + AOW + grp * 128 + ch) = (u32x2){cvtpk(o0, o1), cvtpk(o2, o3)}; }
        }
        __syncthreads();
    }
#undef GM_LOAD
}
__device__ __forceinline__ void combine_phase(const Frame& F, const Args& a) {
    unsigned char* ws = a.ws;
    const bf16_t* OG = (const bf16_t*)(ws + WS_OG); const float* LSE = (const float*)(ws + WS_LSE); bf16_t* YC = (bf16_t*)(ws + WS_YC);
    const int gt = F.vcu * (NWAVES * 64) + F.tid, NGT = F.G * NWAVES * 64;
    for (int it = gt; it < MROWS * 32; it += NGT) {
        const size_t tok = (size_t)(it >> 5); const int j = (it >> 3) & 3, c8 = it & 7;
        const int bb = (int)(tok >> 13), tt = (int)(tok & (SEQ - 1)); const size_t r0 = hrow(bb, tt, j), r1 = hrow(bb, tt, 4 + j), r2 = hrow(bb, tt, 8 + j);
        const float l0 = LSE[r0], l1 = LSE[r1], l2 = LSE[r2];
        const float m = fmaxf(l0, fmaxf(l1, l2));
        float w0 = __builtin_amdgcn_exp2f(l0 - m), w1 = __builtin_amdgcn_exp2f(l1 - m), w2 = __builtin_amdgcn_exp2f(l2 - m);
        const float inv = 1.0f / (w0 + w1 + w2); w0 *= inv; w1 *= inv; w2 *= inv;
        const u32x4 a0 = *(const u32x4*)(OG + r0 * 64 + c8 * 8), a1 = *(const u32x4*)(OG + r1 * 64 + c8 * 8), a2 = *(const u32x4*)(OG + r2 * 64 + c8 * 8);
        u32x4 o;
        o.x = cvtpk(w0 * bflo(a0.x) + w1 * bflo(a1.x) + w2 * bflo(a2.x), w0 * bfhi(a0.x) + w1 * bfhi(a1.x) + w2 * bfhi(a2.x));
        o.y = cvtpk(w0 * bflo(a0.y) + w1 * bflo(a1.y) + w2 * bflo(a2.y), w0 * bfhi(a0.y) + w1 * bfhi(a1.y) + w2 * bfhi(a2.y));
        o.z = cvtpk(w0 * bflo(a0.z) + w1 * bflo(a1.z) + w2 * bflo(a2.z), w0 * bfhi(a0.z) + w1 * bfhi(a1.z) + w2 * bfhi(a2.z));
        o.w = cvtpk(w0 * bflo(a0.w) + w1 * bflo(a1.w) + w2 * bflo(a2.w), w0 * bfhi(a0.w) + w1 * bfhi(a1.w) + w2 * bfhi(a2.w));
        *(u32x4*)(YC + tok * (AOW + GW) + j * 64 + c8 * 8) = o;
    }
}
__device__ __forceinline__ void rowpass1(const Frame& F, const Args& a) {
    unsigned char* ws = a.ws;
    const float* g1 = a.in[10];
    const bf16_t* Y = (const bf16_t*)(ws + WS_Y); const float* ss = (const float*)(ws + WS_SS1); bf16_t* XB = (bf16_t*)(ws + WS_XB); const float* INV0 = (const float*)(ws + WS_RS0); float* INV2 = (float*)(ws + WS_RS2);
    const int gw = F.vcu * NWAVES + F.wave, NGW = F.G * NWAVES;
    f32x4 g1v[4];
#pragma unroll
    for (int j = 0; j < 4; ++j) g1v[j] = *((const f32x4*)g1 + F.lane + 64 * j);
    u32x2 nxv[4], nyv[4]; float npart = 0.f, ninv = 0.f;
#define RP1_LOAD(mm) do { const u32x2* xr_ = (const u32x2*)(XB + (size_t)(mm) * DM) + F.lane; const u32x2* yr_ = (const u32x2*)(Y + (size_t)(mm) * DM) + F.lane; \
        _Pragma("unroll") for (int j = 0; j < 4; ++j) { nxv[j] = xr_[64 * j]; nyv[j] = yr_[64 * j]; } npart = (F.lane < 16) ? ss[(size_t)(mm) * 16 + F.lane] : 0.f; ninv = INV0[mm]; } while (0)
    if (gw < MROWS) RP1_LOAD(gw);
    for (int m = gw; m < MROWS; m += NGW) {
        u32x2 xv[4], yv[4];
#pragma unroll
        for (int j = 0; j < 4; ++j) { xv[j] = nxv[j]; yv[j] = nyv[j]; }
        const float part = npart, inv0 = ninv;
        if (m + NGW < MROWS) RP1_LOAD(m + NGW);
        const float rs1 = 1.0f / sqrtf(wave_sum(part) * (1.f / DM) + EPS);
        f32x4 v[4]; float s = 0.f;
#pragma unroll
        for (int j = 0; j < 4; ++j) { const f32x4 xf = {bflo(xv[j].x), bfhi(xv[j].x), bflo(xv[j].y), bfhi(xv[j].y)}, yf = {bflo(yv[j].x), bfhi(yv[j].x), bflo(yv[j].y), bfhi(yv[j].y)};
            v[j] = xf * inv0 + yf * rs1 * g1v[j]; s += (v[j].x * v[j].x + v[j].y * v[j].y) + (v[j].z * v[j].z + v[j].w * v[j].w); }
        const float ms = wave_sum(s) * (1.f / DM) + EPS; const float rs2 = 1.0f / sqrtf(ms);
        u32x2* xw = (u32x2*)(XB + (size_t)m * DM) + F.lane;
#pragma unroll
        for (int j = 0; j < 4; ++j) xw[64 * j] = (u32x2){cvtpk(v[j].x * rs2, v[j].y * rs2), cvtpk(v[j].z * rs2, v[j].w * rs2)};
        if (F.lane == 0) INV2[m] = sqrtf(ms);
    }
#undef RP1_LOAD
}
__device__ __forceinline__ void rowpass2(const Frame& F, const Args& a) {
    unsigned char* ws = a.ws;
    const float* g4v_ = a.in[14]; const bf16_t* Y2 = (const bf16_t*)(ws + WS_Y2); const bf16_t* XB = (const bf16_t*)(ws + WS_XB); const float* ss = (const float*)(ws + WS_SS2); const float* INV2 = (const float*)(ws + WS_RS2); float* out = a.out;
#ifdef HALF_P9
    if (F.vcu & 1) return;
    const int gw = (F.vcu >> 1) * NWAVES + F.wave, NGW = (F.G / 2) * NWAVES;
#else
    const int gw = F.vcu * NWAVES + F.wave, NGW = F.G * NWAVES;
#endif
    f32x4 gv[4];
#pragma unroll
    for (int j = 0; j < 4; ++j) gv[j] = *((const f32x4*)g4v_ + F.lane + 64 * j);
    u32x2 nxv[4], nyv[4]; float npart = 0.f, ninv = 0.f;
#define RP2_LOAD(mm) do { const u32x2* xr_ = (const u32x2*)(XB + (size_t)(mm) * DM) + F.lane; const u32x2* yr_ = (const u32x2*)(Y2 + (size_t)(mm) * DM) + F.lane; \
        _Pragma("unroll") for (int j = 0; j < 4; ++j) { nxv[j] = xr_[64 * j]; nyv[j] = yr_[64 * j]; } npart = (F.lane < 16) ? ss[(size_t)(mm) * 16 + F.lane] : 0.f; ninv = INV2[mm]; } while (0)
    if (gw < MROWS) RP2_LOAD(gw);
    for (int m = gw; m < MROWS; m += NGW) {
        u32x2 xv[4], yv[4];
#pragma unroll
        for (int j = 0; j < 4; ++j) { xv[j] = nxv[j]; yv[j] = nyv[j]; }
        const float part = npart, inv2 = ninv;
        if (m + NGW < MROWS) RP2_LOAD(m + NGW);
        const float rs = 1.0f / sqrtf(wave_sum(part) * (1.f / DM) + EPS);
        f32x4* orow = (f32x4*)(out + (size_t)m * DM) + F.lane;
#pragma unroll
        for (int j = 0; j < 4; ++j) { const f32x4 xf = {bflo(xv[j].x), bfhi(xv[j].x), bflo(xv[j].y), bfhi(xv[j].y)}, yf = {bflo(yv[j].x), bfhi(yv[j].x), bflo(yv[j].y), bfhi(yv[j].y)};
            orow[64 * j] = xf * inv2 + yf * rs * gv[j]; }
    }
#undef RP2_LOAD
}

constexpr int N_PHASES = 10;
__global__ void __launch_bounds__(NWAVES * 64, 2) fwd_megakernel(Args args) {
    extern __shared__ __attribute__((aligned(16))) unsigned char lds_raw[];
    Frame F;
    F.lds = (LAS unsigned char*)lds_raw;
    F.tid = threadIdx.x; F.lane = F.tid & 63; F.wave = __builtin_amdgcn_readfirstlane(F.tid >> 6);
    F.G = gridDim.x; { const int bx = blockIdx.x; F.vcu = (F.G % 8 == 0) ? (bx % 8) * (F.G / 8) + bx / 8 : bx; }
    unsigned char* ws = args.ws;
    for (int u = F.tid; u < (LDS_BYTES - LDSCTL_OFF) / 4; u += NWAVES * 64) ((LAS unsigned*)(F.lds + LDSCTL_OFF))[u] = 0u;
    __syncthreads();
    if (F.tid < 32) ((LAS float*)(F.lds + INVF_OFF))[F.tid] = c_invfreq[F.tid];
    __syncthreads();
    const int lo = args.ph_lo, hi = args.ph_hi;
    const bool multi = (hi - lo) > 1;
    XcdBarrier bar; bar.bar = (unsigned*)(ws + WS_CTL) + CW_BAR; bar.x = 0; bar.st = nullptr;
    if (multi) bar = xcd_barrier_post((unsigned*)(ws + WS_CTL) + CW_BAR, (volatile LAS unsigned*)(F.lds + MISC_OFF) + 8);
#define IN(k) (lo <= (k) && (k) < hi)
#ifndef PROBE_REP
#define PROBE_REP -1
#endif
#define REPS(k) for (int rep_ = 0; rep_ < ((PROBE_REP == (k)) ? 2 : 1); ++rep_)
#define SEAM(k) do { if (IN(k) && (IN((k) + 1) || PROBE_REP == (k))) xcd_barrier(bar); } while (0)
    if (IN(0)) REPS(0) { p0_prologue(F, args); SEAM(0); }
#ifdef MFMA_BENCH
    {
        bf16x8 af = __builtin_bit_cast(bf16x8, (u32x4){0x3f803f80u + F.lane, 0x3f803f80u, 0x3f803f80u, 0x3f803f80u}), bfr = af;
        f32x4 c[8];
#pragma unroll
        for (int i = 0; i < 8; ++i) c[i] = (f32x4){0.f, 0.f, 0.f, 0.f};
        for (int it = 0; it < MFMA_BENCH; ++it) {
#pragma unroll
            for (int i = 0; i < 8; ++i) c[i] = mfma16(af, bfr, c[i]);
        }
        float s = 0.f;
#pragma unroll
        for (int i = 0; i < 8; ++i) s += c[i][0] + c[i][1] + c[i][2] + c[i][3];
        ((float*)(ws + 952 * MiB))[blockIdx.x * 512 + F.tid] = s;
        xcd_barrier(bar);
    }
#endif
    if (IN(1)) REPS(1) {
        pg8::Gemm g{(bf16_t*)(ws + WS_XB), nullptr, (bf16_t*)(ws + WS_WIN), nullptr, DM / 64, 0, DM, DM};
        pg8::StaticOrder S; S.init(MROWS, INW, F.G, (int)blockIdx.x, 1);
        pg8::EpiP1 E{(bf16_t*)(ws + WS_Q), (bf16_t*)(ws + WS_K), (bf16_t*)(ws + WS_V), (bf16_t*)(ws + WS_U), (bf16_t*)(ws + WS_Z), (bf16_t*)(ws + WS_GA), (bf16_t*)(ws + WS_GB), (f32x2*)(ws + WS_ZST), (const LAS float*)(F.lds + INVF_OFF)};
        pg8::gemm_phase<pg8::EpiP1, true>(F.lds, g, S, E);
        SEAM(1);
    }
    if (IN(2)) REPS(2) { attn_phase(F, args); SEAM(2); }
    if (IN(3)) REPS(3) { gmlp_phase(F, args); combine_phase(F, args); SEAM(3); }
    if (IN(4)) REPS(4) {
        const bf16_t* YC = (const bf16_t*)(ws + WS_YC); const bf16_t* WC = (const bf16_t*)(ws + WS_WCAT);
        pg8::Gemm g{YC, YC + AOW, WC, WC + AOW, AOW / 64, GW / 64, AOW + GW, AOW + GW};
        pg8::StaticOrder S; S.init(MROWS, DM, F.G, (int)blockIdx.x, 2);
        pg8::EpiMerge E{(const bf16_t*)(ws + WS_GA), (const bf16_t*)(ws + WS_GB), (bf16_t*)(ws + WS_MG)};
        pg8::gemm_phase<pg8::EpiMerge, true>(F.lds, g, S, E);
        SEAM(4);
    }
    if (IN(5)) REPS(5) {
        pg8::Gemm g{(bf16_t*)(ws + WS_MG), nullptr, (bf16_t*)(ws + WS_WOUT), nullptr, DM / 64, 0, DM, DM};
        pg8::StaticOrder S; S.init(MROWS, DM, F.G, (int)blockIdx.x, 1);
        pg8::EpiYss E{(bf16_t*)(ws + WS_Y), (float*)(ws + WS_SS1)};
        pg8::gemm_phase<pg8::EpiYss, true>(F.lds, g, S, E);
        SEAM(5);
    }
    if (IN(6)) REPS(6) { rowpass1(F, args); SEAM(6); }
    if (IN(7)) REPS(7) {
        pg8::Gemm g{(bf16_t*)(ws + WS_XB), nullptr, (bf16_t*)(ws + WS_WMI), nullptr, DM / 64, 0, DM, DM};
        pg8::StaticOrder S; S.init(MROWS, DFF, F.G, (int)blockIdx.x, 1);
        pg8::EpiRelu2 E{(bf16_t*)(ws + WS_H)};
        pg8::gemm_phase<pg8::EpiRelu2, true>(F.lds, g, S, E);
        SEAM(7);
    }
    if (IN(8)) REPS(8) {
        pg8::Gemm g{(bf16_t*)(ws + WS_H), nullptr, (bf16_t*)(ws + WS_WMO), nullptr, DFF / 64, 0, DFF, DFF};
        pg8::StaticOrder S; S.init(MROWS, DM, F.G, (int)blockIdx.x, 1);
        pg8::EpiYss E{(bf16_t*)(ws + WS_Y2), (float*)(ws + WS_SS2)};
        pg8::gemm_phase<pg8::EpiYss, true>(F.lds, g, S, E);
        SEAM(8);
    }
    if (IN(9)) REPS(9) { rowpass2(F, args); }
#undef IN
#undef SEAM
}

#ifndef MK_PER_PHASE
#define MK_PER_PHASE 0
#endif
extern "C" void kernel_launch(void* const* d_in, const int* in_sizes, int n_in, void* d_out, int out_size, void* d_ws, size_t ws_size, hipStream_t stream) {
    static int grid = 0;
    if (grid == 0) {
        if (n_in != 15 || in_sizes[0] != MROWS * DM || out_size != MROWS * DM || ws_size < WS_END) { fprintf(stderr, "kernel_launch: unexpected shapes (n_in %d, in0 %d, out %d, ws %zu)\n", n_in, n_in > 0 ? in_sizes[0] : -1, out_size, ws_size); grid = -1; return; }
        int dev = 0, cus = 0, per_cu = 0;
        if (hipGetDevice(&dev) != hipSuccess || hipDeviceGetAttribute(&cus, hipDeviceAttributeMultiprocessorCount, dev) != hipSuccess) { grid = -1; return; }
        if (hipFuncSetAttribute((const void*)fwd_megakernel, hipFuncAttributeMaxDynamicSharedMemorySize, LDS_BYTES) != hipSuccess) { fprintf(stderr, "kernel_launch: hipFuncSetAttribute failed\n"); grid = -1; return; }
        if (hipOccupancyMaxActiveBlocksPerMultiprocessor(&per_cu, (const void*)fwd_megakernel, NWAVES * 64, LDS_BYTES) != hipSuccess || per_cu < 1) { fprintf(stderr, "kernel_launch: occupancy query says %d blocks per CU\n", per_cu); }
        (void)hipGetLastError();
        grid = cus;
    }
    if (grid < 0) return;
    (void)hipMemsetAsync((char*)d_ws + WS_CTL, 0, CTL_ZERO_BYTES, stream);
    Args a{};
    for (int i = 0; i < 15; ++i) a.in[i] = (const float*)d_in[i];
    a.out = (float*)d_out; a.ws = (unsigned char*)d_ws;
#if MK_PER_PHASE
    for (int p = 0; p < N_PHASES; ++p) { a.ph_lo = p; a.ph_hi = p + 1; hipLaunchKernelGGL(fwd_megakernel, dim3(grid), dim3(NWAVES * 64), LDS_BYTES, stream, a); }
#else
    a.ph_lo = 0; a.ph_hi = N_PHASES; hipLaunchKernelGGL(fwd_megakernel, dim3(grid), dim3(NWAVES * 64), LDS_BYTES, stream, a);
#endif
}
```
